# Optimizing an MI355X kernel written in HIP

```python
import jax, jax.numpy as jnp
from jax import lax
import numpy as np

D_MODEL = 1024
BATCH = 32
SEQ = 2048
DEPTH = 1
DEC_BATCH = 8
DEC_SEQ = 32
PAST_LEN = 1024

CHUNK = 64
N_META = 16
MIX_WIDTH = D_MODEL
HG_WIDTH = MIX_WIDTH // 2
HG_HEADS = 4
HG_DIM = HG_WIDTH // HG_HEADS
ATT_WIDTH = MIX_WIDTH - HG_WIDTH
ATT_HEAD_DIM = 64
N_Q_HEADS = ATT_WIDTH // ATT_HEAD_DIM
N_KV_HEADS = 2
Q_PER_KV = N_Q_HEADS // N_KV_HEADS
KV_WIDTH = N_KV_HEADS * ATT_HEAD_DIM
WINDOW = 128
WIN_CHUNKS = WINDOW // CHUNK
ROPE_THETA = 10000.0
D_FF = -(-8 * D_MODEL // (3 * 256)) * 256
IN_COLS = 4 * HG_WIDTH + ATT_WIDTH + 2 * KV_WIDTH
EPS = 1e-6

kernel_name = 'hymba_hgrn2_swa_sink_streaming_step'


def rmsnorm(x, g):
    xf = x.astype(jnp.float32)
    y = xf * lax.rsqrt(jnp.mean(xf * xf, axis=-1, keepdims=True) + EPS)
    return y.astype(x.dtype) * g.astype(x.dtype)


def rope(x, pos):
    inv = ROPE_THETA ** (-jnp.arange(0, ATT_HEAD_DIM, 2, dtype=jnp.float32) / ATT_HEAD_DIM)
    ang = pos.astype(jnp.float32)[:, None] * inv[None, :]
    ang = jnp.concatenate([ang, ang], axis=-1)[:, None, :]
    xf = x.astype(jnp.float32)
    x1, x2 = jnp.split(xf, 2, axis=-1)
    rot = jnp.concatenate([-x2, x1], axis=-1)
    return (xf * jnp.cos(ang) + rot * jnp.sin(ang)).astype(x.dtype)


def project(hn, w, lb, pos):
    lead = hn.shape[:-1]
    idx = [HG_WIDTH, 2 * HG_WIDTH, 3 * HG_WIDTH, 4 * HG_WIDTH,
           4 * HG_WIDTH + ATT_WIDTH, 4 * HG_WIDTH + ATT_WIDTH + KV_WIDTH]
    hq, hf, hi, hg, aq, ak, av = jnp.split(hn @ w, idx, axis=-1)
    heads = lambda t: t.reshape(*lead, HG_HEADS, HG_DIM)
    fgate = lb + (1.0 - lb) * jax.nn.sigmoid(hf.astype(jnp.float32))
    q_h = heads(jax.nn.silu(hq.astype(jnp.float32)))
    logf = heads(jnp.log(fgate))
    k_h = heads(1.0 - fgate)
    v_h = heads(hi)
    g_h = heads(hg)
    aq = rope(aq.reshape(*lead, N_Q_HEADS, ATT_HEAD_DIM), pos).reshape(*lead, N_KV_HEADS, Q_PER_KV, ATT_HEAD_DIM)
    ak = rope(ak.reshape(*lead, N_KV_HEADS, ATT_HEAD_DIM), pos)
    av = av.reshape(*lead, N_KV_HEADS, ATT_HEAD_DIM)
    return q_h, logf, k_h, v_h, g_h, aq, ak, av


def hgrn_block(q, logf, k, v, S0):
    q, k, v = (t.astype(jnp.float32) for t in (q, k, v))
    L = q.shape[1]
    b = jnp.cumsum(logf.astype(jnp.float32), axis=1)
    o_inter = jnp.einsum('blhk,bhkv->blhv', q * jnp.exp(b), S0)
    causal = jnp.tril(jnp.ones((L, L), dtype=bool))
    diff = jnp.minimum(b[:, :, None] - b[:, None, :], 0.0)
    decay = jnp.where(causal[None, :, :, None, None], jnp.exp(diff), 0.0)
    A = jnp.einsum('bthk,btshk,bshk->bhts', q, decay, k)
    o_intra = jnp.einsum('bhts,bshv->bthv', A, v)
    bL = b[:, -1]
    S_new = jnp.exp(bL)[..., None] * S0 + jnp.einsum('bshk,bshv->bhkv', k * jnp.exp(bL[:, None] - b), v)
    return o_inter + o_intra, S_new


def hgrn_readout(o, g, gain):
    on = o * lax.rsqrt(jnp.mean(o * o, axis=-1, keepdims=True) + EPS)
    y = on * gain.astype(jnp.float32).reshape(HG_HEADS, HG_DIM) * jax.nn.silu(g.astype(jnp.float32))
    return y.reshape(*o.shape[:-2], HG_WIDTH)


def sink_attention(q, k, v, sinks, valid):
    s = jnp.einsum('...qgrd,...kgd->...grqk', q, k).astype(jnp.float32) * (ATT_HEAD_DIM ** -0.5)
    if valid is not None:
        s = jnp.where(valid[..., None, None, None, :], s, jnp.finfo(jnp.float32).min)
    sink = jnp.broadcast_to(sinks.astype(jnp.float32)[:, :, None, None], s.shape[:-1] + (1,))
    p = jax.nn.softmax(jnp.concatenate([s, sink], axis=-1), axis=-1)[..., :-1]
    return jnp.einsum('...grqk,...kgd->...qgrd', p.astype(v.dtype), v)


def finish_layer(h, o_hg, g_hg, o_att, hg_norm_l, attn_norm_l, w_out_l, norm2_l, w_ffn_in_l, w_ffn_out_l):
    mixed = jnp.concatenate([hgrn_readout(o_hg, g_hg, hg_norm_l).astype(h.dtype),
                             rmsnorm(o_att, attn_norm_l)], axis=-1) @ w_out_l
    h = h + mixed
    gate, up = jnp.split(rmsnorm(h, norm2_l) @ w_ffn_in_l, 2, axis=-1)
    return h + (jax.nn.silu(gate) * up) @ w_ffn_out_l


def band(t, nc):
    B = t.shape[0]
    pad = jnp.zeros((B, WIN_CHUNKS * CHUNK) + t.shape[2:], t.dtype)
    tp = jnp.concatenate([pad, t], axis=1).reshape(B, nc + WIN_CHUNKS, CHUNK, *t.shape[2:])
    return jnp.concatenate([tp[:, j:j + nc] for j in range(WIN_CHUNKS + 1)], axis=2)


def setup_inputs(seed: int = 0) -> dict:
    key = jax.random.key(seed)
    ks = jax.random.split(key, 24)
    n = lambda i, shape, s=1.0: jax.random.normal(ks[i], shape, jnp.float32) * s
    win_keep = min(WINDOW, PAST_LEN)
    kv_shape = lambda L: (DEPTH, DEC_BATCH, L, N_KV_HEADS, ATT_HEAD_DIM)
    return {
        'x_prompt': n(0, (BATCH, SEQ, D_MODEL)),
        'x_sample': n(1, (DEC_BATCH, DEC_SEQ, D_MODEL)),
        'cache_meta_k': n(2, kv_shape(N_META)),
        'cache_meta_v': n(3, kv_shape(N_META)),
        'cache_win_k': n(4, kv_shape(win_keep)),
        'cache_win_v': n(5, kv_shape(win_keep)),
        'state_hgrn': n(6, (DEPTH, DEC_BATCH, HG_HEADS, HG_DIM, HG_DIM), 0.3),
        'meta_tokens': n(7, (N_META, D_MODEL)),
        'norm1': 1.0 + n(8, (DEPTH, D_MODEL), 0.02),
        'w_in': n(9, (DEPTH, D_MODEL, IN_COLS), D_MODEL ** -0.5),
        'lb_param': n(10, (DEPTH + 1, HG_WIDTH), 0.1),
        'hg_norm': 1.0 + n(11, (DEPTH, HG_WIDTH), 0.02),
        'attn_sinks': n(12, (DEPTH, N_KV_HEADS, Q_PER_KV), 0.5),
        'attn_norm': 1.0 + n(13, (DEPTH, ATT_WIDTH), 0.02),
        'w_out': n(14, (DEPTH, MIX_WIDTH, D_MODEL), MIX_WIDTH ** -0.5),
        'norm2': 1.0 + n(15, (DEPTH, D_MODEL), 0.02),
        'w_ffn_in': n(16, (DEPTH, D_MODEL, 2 * D_FF), D_MODEL ** -0.5),
        'w_ffn_out': n(17, (DEPTH, D_FF, D_MODEL), D_FF ** -0.5),
        'final_norm': 1.0 + n(18, (D_MODEL,), 0.02),
    }


def reference(x_prompt, x_sample, cache_meta_k, cache_meta_v, cache_win_k, cache_win_v, state_hgrn,
              meta_tokens, norm1, w_in, lb_param, hg_norm, attn_sinks, attn_norm, w_out, norm2,
              w_ffn_in, w_ffn_out, final_norm):
    B, S, _ = x_prompt.shape
    Bd, T, _ = x_sample.shape
    nc = S // CHUNK
    keep = min(WINDOW, S)
    lb_all = jnp.cumsum(jax.nn.softmax(lb_param.astype(jnp.float32), axis=0), axis=0)
    pos_meta = jnp.arange(N_META)
    pos_p = N_META + jnp.arange(S)
    pos_s = N_META + PAST_LEN + jnp.arange(T)
    band_valid = (jnp.arange(nc)[:, None] + jnp.arange((WIN_CHUNKS + 1) * CHUNK)[None, :] // CHUNK - WIN_CHUNKS) >= 0
    valid_p = jnp.concatenate([jnp.ones((nc, N_META), dtype=bool), band_valid], axis=-1)

    h = x_prompt
    h_meta = meta_tokens[None].astype(x_prompt.dtype)
    hs = x_sample
    p_mk, p_mv, p_wk, p_wv, p_st, s_nk, s_nv, s_st = ([] for _ in range(8))
    for l in range(DEPTH):
        lb = lb_all[l]
        hm = rmsnorm(h_meta, norm1[l])
        mq, mlogf, mk, mv, mg, maq, mak, mav = project(hm, w_in[l], lb, pos_meta)
        mo_hg, S_meta = hgrn_block(mq, mlogf, mk, mv, jnp.zeros((1, HG_HEADS, HG_DIM, HG_DIM), jnp.float32))
        hn = rmsnorm(h, norm1[l])
        q, logf, k, v, g, aq, ak, av = project(hn, w_in[l], lb, pos_p)
        to_blocks = lambda t: t.reshape(B, nc, CHUNK, *t.shape[2:]).swapaxes(0, 1)

        def step(Sc, blk):
            o, Sn = hgrn_block(*blk, Sc)
            return Sn, o

        S_fin, o_blocks = lax.scan(step, jnp.broadcast_to(S_meta, (B, HG_HEADS, HG_DIM, HG_DIM)),
                                   (to_blocks(q), to_blocks(logf), to_blocks(k), to_blocks(v)))
        o_hg = o_blocks.swapaxes(0, 1).reshape(B, S, HG_HEADS, HG_DIM)
        qb = aq.reshape(B, nc, CHUNK, N_KV_HEADS, Q_PER_KV, ATT_HEAD_DIM)
        meta_kb = jnp.broadcast_to(mak[:, None], (B, nc, N_META, N_KV_HEADS, ATT_HEAD_DIM))
        meta_vb = jnp.broadcast_to(mav[:, None], (B, nc, N_META, N_KV_HEADS, ATT_HEAD_DIM))
        keys = jnp.concatenate([meta_kb, band(ak, nc)], axis=2)
        vals = jnp.concatenate([meta_vb, band(av, nc)], axis=2)
        o_att = sink_attention(qb, keys, vals, attn_sinks[l], valid_p).reshape(B, S, ATT_WIDTH)
        h = finish_layer(h, o_hg, g, o_att, hg_norm[l], attn_norm[l], w_out[l], norm2[l], w_ffn_in[l], w_ffn_out[l])
        p_mk.append(jnp.broadcast_to(mak, (B, N_META, N_KV_HEADS, ATT_HEAD_DIM)))
        p_mv.append(jnp.broadcast_to(mav, (B, N_META, N_KV_HEADS, ATT_HEAD_DIM)))
        p_wk.append(ak[:, S - keep:])
        p_wv.append(av[:, S - keep:])
        p_st.append(S_fin.astype(x_prompt.dtype))
        if l < DEPTH - 1:
            mo_att = sink_attention(maq, mak, mav, attn_sinks[l], None).reshape(1, N_META, ATT_WIDTH)
            h_meta = finish_layer(h_meta, mo_hg, mg, mo_att, hg_norm[l], attn_norm[l], w_out[l], norm2[l], w_ffn_in[l], w_ffn_out[l])
        hn_s = rmsnorm(hs, norm1[l])
        sq, slogf, sk, sv, sg, saq, sak, sav = project(hn_s, w_in[l], lb, pos_s)
        so_hg, S_s = hgrn_block(sq, slogf, sk, sv, state_hgrn[l].astype(jnp.float32))
        skeys = jnp.concatenate([cache_meta_k[l], cache_win_k[l], sak], axis=1)
        svals = jnp.concatenate([cache_meta_v[l], cache_win_v[l], sav], axis=1)
        so_att = sink_attention(saq, skeys, svals, attn_sinks[l], None).reshape(Bd, T, ATT_WIDTH)
        hs = finish_layer(hs, so_hg, sg, so_att, hg_norm[l], attn_norm[l], w_out[l], norm2[l], w_ffn_in[l], w_ffn_out[l])
        s_nk.append(sak)
        s_nv.append(sav)
        s_st.append(S_s.astype(state_hgrn.dtype))

    y_prompt = rmsnorm(h, final_norm)
    y_sample = rmsnorm(hs, final_norm)
    return (y_prompt, y_sample, jnp.stack(p_mk), jnp.stack(p_mv), jnp.stack(p_wk), jnp.stack(p_wv),
            jnp.stack(p_st), jnp.stack(s_nk), jnp.stack(s_nv), jnp.stack(s_st))
```

```cpp
#include <hip/hip_runtime.h>
#include <hip/hip_cooperative_groups.h>
#include <cstdio>
#include <cstdint>
namespace cg = cooperative_groups;

#define LAS __attribute__((address_space(3)))
typedef unsigned short bf16_t;
typedef short bf16x8 __attribute__((ext_vector_type(8)));
typedef short s16x4 __attribute__((ext_vector_type(4)));
typedef float f32x4 __attribute__((ext_vector_type(4)));
typedef float f32x2 __attribute__((ext_vector_type(2)));
typedef unsigned u32x4 __attribute__((ext_vector_type(4)));
typedef unsigned u32x2 __attribute__((ext_vector_type(2)));

constexpr int DM = 1024, NBATCH = 32, SEQ = 2048, DBATCH = 8, DSEQ = 32, NMETA = 16, PAST = 1024;
constexpr int ROW_S = NBATCH * SEQ;
constexpr int ROW_M = ROW_S + DBATCH * DSEQ;
constexpr int ROW_END = ROW_M + NMETA;
constexpr int RTOT = 258 * 256;
constexpr int MROWS = 257 * 256;
constexpr int NIN = 2816, DFF = 2816, NFF2 = 5632;
constexpr int NPOS = 2064;
constexpr float EPS = 1e-6f;
constexpr float LOG2E = 1.4426950408889634f, QSCALE = 0.125f * LOG2E;
constexpr size_t OFF_Y = 0, OFF_PMK = 67371008, OFF_PMV = 67436544, OFF_PWK = 67502080, OFF_PWV = 68026368, OFF_PST = 68550656,
                 OFF_SNK = 70647808, OFF_SNV = 70680576, OFF_SST = 70713344;
constexpr size_t al256(size_t x) { return (x + 255) & ~(size_t)255; }
constexpr size_t WS_CTL = 0;
constexpr size_t WS_LB = 4096;
constexpr size_t WS_ROPE = WS_LB + 2048;
constexpr size_t WS_SS1 = al256(WS_ROPE + (size_t)NPOS * 32 * 8);
constexpr size_t WS_SS2 = al256(WS_SS1 + (size_t)RTOT * 4);
constexpr size_t WS_GINV = al256(WS_SS2 + (size_t)RTOT * 4);
constexpr size_t WS_BAR = al256(WS_GINV + (size_t)DM * 4);
constexpr size_t WS_BAR_BYTES = 16384;
constexpr size_t WS_WIN = al256(WS_BAR + WS_BAR_BYTES);
constexpr size_t WS_WOUT = WS_WIN + (size_t)NIN * DM * 2;
constexpr size_t WS_WFI = WS_WOUT + (size_t)DM * DM * 2;
constexpr size_t WS_WFO = WS_WFI + (size_t)NFF2 * DM * 2;
constexpr size_t WS_XN = WS_WFO + (size_t)DM * DFF * 2;
constexpr size_t WS_BIG = WS_XN + (size_t)RTOT * DM * 2;
constexpr size_t WS_QH = WS_BIG;
constexpr size_t WS_LF = WS_QH + (size_t)RTOT * 512 * 2;
constexpr size_t WS_VH = WS_LF + (size_t)RTOT * 512 * 4;
constexpr size_t WS_GH = WS_VH + (size_t)RTOT * 512 * 2;
constexpr size_t WS_AQ = WS_GH + (size_t)RTOT * 512 * 2;
constexpr size_t WS_BIG_END = WS_AQ + (size_t)RTOT * 512 * 2;
constexpr size_t WS_ACT = WS_BIG;
static_assert(WS_ACT + (size_t)RTOT * DFF * 2 <= WS_BIG_END, "ACT overlay");
constexpr size_t WS_AK = WS_BIG_END;
constexpr size_t WS_AV = WS_AK + (size_t)RTOT * 128 * 2;
constexpr size_t WS_MIX = WS_AV + (size_t)RTOT * 128 * 2;
constexpr size_t WS_END = WS_MIX + (size_t)RTOT * DM * 2;
static_assert(WS_END <= (size_t)1 << 30, "workspace");

constexpr int LDS_BYTES = 147456;
#define REP_P1 1
#define REP_P2 1
#define REP_P4 1

struct Params { const float* in[19]; float* out; unsigned char* ws; };

__device__ __forceinline__ unsigned cvt_pk_bf16(float lo, float hi) { unsigned r; asm volatile("v_cvt_pk_bf16_f32 %0, %1, %2" : "=v"(r) : "v"(lo), "v"(hi)); return r; }
typedef _Float16 f16x2 __attribute__((ext_vector_type(2)));
__device__ __forceinline__ unsigned pk_f16(float a, float b) { f16x2 h; h.x = (_Float16)a; h.y = (_Float16)b; return __builtin_bit_cast(unsigned, h); }
__device__ __forceinline__ float bf2f(unsigned short b) { return __builtin_bit_cast(float, (unsigned)b << 16); }
__device__ __forceinline__ float bflo(unsigned u) { return __builtin_bit_cast(float, u << 16); }
__device__ __forceinline__ float bfhi(unsigned u) { return __builtin_bit_cast(float, u & 0xffff0000u); }
__device__ __forceinline__ float sigmoidf_(float v) { return __builtin_amdgcn_rcpf(1.0f + __expf(-v)); }
__device__ __forceinline__ float siluf_(float v) { return v * sigmoidf_(v); }
__device__ __forceinline__ float wave_sum(float v) {
#pragma unroll
    for (int o = 1; o < 64; o <<= 1) v += __shfl_xor(v, o);
    return v;
}
#define LDS_WAIT() asm volatile("s_waitcnt lgkmcnt(0)" ::: "memory")

namespace pg8 {
constexpr int BM = 256, BK = 64, HALF = 128, HTB = HALF * BK * 2, NXCD = 8, WGM = 8;
__host__ __device__ __forceinline__ int lds_byte(int r, int c) { const int st = (r >> 4) * 2 + (c >> 5), rr = r & 15, cc = c & 31, ob = rr * 64 + cc * 2; return st * 1024 + (ob ^ (((ob >> 9) & 1) << 5)); }
__host__ __device__ __forceinline__ void stage_rc(int b, int& R, int& C) { const int st = b / 1024, sb = b % 1024, swz = sb ^ (((sb >> 9) & 1) << 5); R = (st >> 1) * 16 + swz / 64; C = (st & 1) * 32 + (swz % 64) / 2; }
__host__ __device__ __forceinline__ int perm32(int rho) { const int n = rho >> 4, i = rho & 15; return 8 * (i >> 2) + 4 * n + (i & 3); }

struct Unit { int pm, pn, ko, nt; };
struct Gemm { const bf16_t* A; const bf16_t* Bt; int M, N, K; };

struct StaticOrder {
    int nM, nN, nwg, G, c, ntk;
    __device__ void init(int M, int N, int K, int G_, int c_) { nM = M / BM; nN = N / BM; nwg = nM * nN; G = G_; c = c_; ntk = K / BK; }
    __device__ bool next(int i, Unit& u) const {
        const long L = (long)i * G + c; if (L >= nwg) return false;
        int wgid = (int)L; { const int q = nwg / NXCD, r = nwg % NXCD, xcd = wgid % NXCD, off = wgid / NXCD; wgid = (xcd < r ? xcd * (q + 1) : r * (q + 1) + (xcd - r) * q) + off; }
        const int nig = WGM * nN, gid = wgid / nig, fm = gid * WGM, gsz = (nM - fm) < WGM ? (nM - fm) : WGM;
        u.pm = fm + ((wgid % nig) % gsz); u.pn = (wgid % nig) / gsz; u.ko = 0; u.nt = ntk; return true;
    }
};
struct DownOrder {
    StaticOrder P; int G, c;
    __device__ void init(int G_, int c_) { P.init(256 * 256, DM, DFF, G_, c_); G = G_; c = c_; }
    __device__ bool next(int i, Unit& u) const {
        const long L = (long)i * G + c; if (L < P.nwg) return P.next(i, u);
        const int x = (int)(L - P.nwg); if (x >= 44) return false;
        u.pm = 256; u.pn = x & 3; u.ko = (x >> 2) * 256; u.nt = 4; return true;
    }
};

template <class Epi, class Sched>
__device__ __forceinline__ void gemm_phase(LAS unsigned char* lds, const Gemm g, const Sched& S, const Epi& E) {
    int tid = threadIdx.x; asm volatile("" : "+v"(tid));
    const int wid = __builtin_amdgcn_readfirstlane(tid >> 6), lane = tid & 63, wr = wid >> 2, wc = wid & 3, fr = lane & 15, fq = lane >> 4;
    const int K = g.K;
    unsigned voffA[2], voffB[2];
#pragma unroll
    for (int i = 0; i < 2; ++i) { int R, C; stage_rc(tid * 16 + i * 8192, R, C); const int Rb = (R & ~31) + perm32(R & 31);
        voffA[i] = (unsigned)(R * K + C) * 2u; voffB[i] = (unsigned)(Rb * K + C) * 2u; }
    const size_t kstep = (size_t)(BK * 2);
    const size_t hstep = (size_t)HALF * K * 2;
    const size_t tstep = 2 * hstep;
    const unsigned ldsw = (unsigned)wid * 1024u;
    const int aoff = lds_byte(wr * 64 + fr, fq * 8), boff = lds_byte(wc * 32 + fr, fq * 8);
#define PG8_SA(b, h) (((b) * 2 + (h)) * HTB)
#define PG8_SB(b, h) ((4 + (b) * 2 + (h)) * HTB)
#define PG8_STAGE(bufoff, gbase, voff) do { _Pragma("unroll") for (int _i = 0; _i < 2; ++_i) \
        __builtin_amdgcn_global_load_lds((const unsigned*)((const char*)(gbase) + (voff)[_i]), (LAS unsigned*)(lds + (bufoff) + ldsw + _i * 8192), 16, 0, 0); } while (0)
#define PG8_LDA(dst, b, h) do { _Pragma("unroll") for (int m = 0; m < 4; ++m) _Pragma("unroll") for (int k = 0; k < 2; ++k) dst[m][k] = *(const LAS bf16x8*)(lds + PG8_SA(b, h) + aoff + m * 2048 + k * 1024); } while (0)
#define PG8_LDB(dst, b, h) do { _Pragma("unroll") for (int n = 0; n < 2; ++n) _Pragma("unroll") for (int k = 0; k < 2; ++k) dst[n][k] = *(const LAS bf16x8*)(lds + PG8_SB(b, h) + boff + n * 2048 + k * 1024); } while (0)
#define PG8_MMA(ai, bj, At, Bt) do { __builtin_amdgcn_s_setprio(1); _Pragma("unroll") for (int m = 0; m < 4; ++m) _Pragma("unroll") for (int n = 0; n < 2; ++n) _Pragma("unroll") for (int k = 0; k < 2; ++k) \
        acc[ai][bj][m][n] = __builtin_amdgcn_mfma_f32_16x16x32_bf16(Bt[n][k], At[m][k], acc[ai][bj][m][n], 0, 0, 0); __builtin_amdgcn_s_setprio(0); } while (0)
#define PG8_WAIT_V(n) asm volatile("s_waitcnt vmcnt(" #n ")" ::: "memory")
#define PG8_WAIT_L(n) asm volatile("s_waitcnt lgkmcnt(" #n ")" ::: "memory")
#define PG8_BAR __builtin_amdgcn_s_barrier()
#define PG8_SCHED __builtin_amdgcn_sched_barrier(0)
    Unit cur, nxt; int ui = 0;
    if (!S.next(0, cur)) return;
    f32x4 acc[2][2][4][2];
#pragma unroll
    for (int a = 0; a < 2; ++a)
#pragma unroll
        for (int b = 0; b < 2; ++b)
#pragma unroll
            for (int m = 0; m < 4; ++m)
#pragma unroll
                for (int n = 0; n < 2; ++n) acc[a][b][m][n] = (f32x4){0.f, 0.f, 0.f, 0.f};
    bf16x8 At[4][2], B0[2][2], B1[2][2];
    const char* cA = (const char*)g.A + (size_t)cur.pm * tstep + (size_t)cur.ko * 2; const char* cB = (const char*)g.Bt + (size_t)cur.pn * tstep + (size_t)cur.ko * 2;
    PG8_STAGE(PG8_SB(0, 0), cB, voffB); PG8_STAGE(PG8_SB(0, 1), cB + hstep, voffB); PG8_STAGE(PG8_SA(0, 0), cA, voffA); PG8_STAGE(PG8_SA(0, 1), cA + hstep, voffA);
    if (wr == 1) PG8_BAR;
    PG8_WAIT_V(2); PG8_BAR;
    PG8_STAGE(PG8_SB(1, 0), cB + kstep, voffB); PG8_STAGE(PG8_SA(1, 0), cA + kstep, voffA); PG8_STAGE(PG8_SB(1, 1), cB + hstep + kstep, voffB);
    PG8_WAIT_V(6); PG8_BAR;
    for (;;) {
        const bool has_next = S.next(ui + 1, nxt);
        const char* nA = has_next ? (const char*)g.A + (size_t)nxt.pm * tstep + (size_t)nxt.ko * 2 : cA; const char* nB = has_next ? (const char*)g.Bt + (size_t)nxt.pn * tstep + (size_t)nxt.ko * 2 : cB;
        const int nt = cur.nt;
        for (int t = 0; t < nt; t += 2) {
            const bool last = (t == nt - 2);
            const char* a1 = cA + (size_t)(t + 1) * kstep;
            const char* a2 = last ? nA : cA + (size_t)(t + 2) * kstep; const char* b2 = last ? nB : cB + (size_t)(t + 2) * kstep;
            const char* a3 = a2 + kstep; const char* b3 = b2 + kstep;
            PG8_LDB(B0, 0, 0); PG8_LDB(B1, 0, 1); PG8_SCHED; PG8_LDA(At, 0, 0); PG8_STAGE(PG8_SA(1, 1), a1 + hstep, voffA);
            PG8_WAIT_V(8); PG8_WAIT_L(0); PG8_BAR; PG8_MMA(0, 0, At, B0); PG8_MMA(0, 1, At, B1); PG8_BAR; PG8_SCHED;
            PG8_LDA(At, 0, 1); PG8_STAGE(PG8_SB(0, 0), b2, voffB); PG8_STAGE(PG8_SB(0, 1), b2 + hstep, voffB); PG8_STAGE(PG8_SA(0, 0), a2, voffA);
            PG8_WAIT_V(8); PG8_WAIT_L(0); PG8_BAR; PG8_MMA(1, 0, At, B0); PG8_MMA(1, 1, At, B1); PG8_BAR; PG8_SCHED;
            PG8_LDB(B0, 1, 0); PG8_LDB(B1, 1, 1); PG8_SCHED; PG8_LDA(At, 1, 0); PG8_STAGE(PG8_SA(0, 1), a2 + hstep, voffA);
            PG8_WAIT_V(8); PG8_WAIT_L(0); PG8_BAR; PG8_MMA(0, 0, At, B0); PG8_MMA(0, 1, At, B1); PG8_BAR; PG8_SCHED;
            PG8_LDA(At, 1, 1); PG8_STAGE(PG8_SB(1, 0), b3, voffB); PG8_STAGE(PG8_SB(1, 1), b3 + hstep, voffB); PG8_STAGE(PG8_SA(1, 0), a3, voffA);
            PG8_WAIT_V(8); PG8_WAIT_L(0); PG8_BAR; PG8_MMA(1, 0, At, B0); PG8_MMA(1, 1, At, B1); PG8_BAR; PG8_SCHED;
        }
        if (wr == 0) PG8_BAR;
        E(acc, cur, wr, wc, fr, fq);
        if (!has_next) break;
#pragma unroll
        for (int a = 0; a < 2; ++a)
#pragma unroll
            for (int b = 0; b < 2; ++b)
#pragma unroll
                for (int m = 0; m < 4; ++m)
#pragma unroll
                    for (int n = 0; n < 2; ++n) acc[a][b][m][n] = (f32x4){0.f, 0.f, 0.f, 0.f};
        cur = nxt; cA = nA; cB = nB; ++ui;
        if (wr == 1) PG8_BAR;
    }
    PG8_WAIT_V(0);
    PG8_BAR;
#undef PG8_SA
#undef PG8_SB
#undef PG8_STAGE
#undef PG8_LDA
#undef PG8_LDB
#undef PG8_MMA
#undef PG8_WAIT_V
#undef PG8_WAIT_L
#undef PG8_BAR
#undef PG8_SCHED
}
}

__device__ __forceinline__ u32x4 pack8(const f32x4& a, const f32x4& b) {
    u32x4 w; w.x = cvt_pk_bf16(a[0], a[1]); w.y = cvt_pk_bf16(a[2], a[3]); w.z = cvt_pk_bf16(b[0], b[1]); w.w = cvt_pk_bf16(b[2], b[3]); return w;
}
__device__ __forceinline__ u32x2 pack4(const f32x4& a) { u32x2 w; w.x = cvt_pk_bf16(a[0], a[1]); w.y = cvt_pk_bf16(a[2], a[3]); return w; }

__device__ __forceinline__ int row_pos(int row) {
    int pos;
    if (row < ROW_S) pos = NMETA + (row & (SEQ - 1));
    else if (row < ROW_M) pos = NMETA + PAST + ((row - ROW_S) & (DSEQ - 1));
    else pos = row - ROW_M;
    return pos < NPOS ? pos : NPOS - 1;
}
__device__ __forceinline__ void kv_out(float* out, size_t off_pw, size_t off_sn, size_t off_pm, int row, int c, const f32x4& v) {
    if (row < ROW_S) { const int s = row & (SEQ - 1); if (s >= SEQ - 128) { const int b = row >> 11; *(f32x4*)(out + off_pw + ((size_t)(b * 128 + s - (SEQ - 128))) * 128 + c) = v; } }
    else if (row < ROW_M) { *(f32x4*)(out + off_sn + (size_t)(row - ROW_S) * 128 + c) = v; }
    else if (row < ROW_END) { const int m = row - ROW_M;
        for (int b = 0; b < NBATCH; ++b) *(f32x4*)(out + off_pm + (size_t)(b * NMETA + m) * 128 + c) = v; }
}

struct EpiIn {
    unsigned char* ws; float* out;
    __device__ __forceinline__ void rope4(const f32x4& x1, const f32x4& x2, const f32x4& cs0, const f32x4& cs1, f32x4& o1, f32x4& o2) const {
        o1[0] = x1[0] * cs0[0] - x2[0] * cs0[1]; o2[0] = x2[0] * cs0[0] + x1[0] * cs0[1];
        o1[1] = x1[1] * cs0[2] - x2[1] * cs0[3]; o2[1] = x2[1] * cs0[2] + x1[1] * cs0[3];
        o1[2] = x1[2] * cs1[0] - x2[2] * cs1[1]; o2[2] = x2[2] * cs1[0] + x1[2] * cs1[1];
        o1[3] = x1[3] * cs1[2] - x2[3] * cs1[3]; o2[3] = x2[3] * cs1[2] + x1[3] * cs1[3];
    }
    __device__ __forceinline__ void operator()(const f32x4 (&acc)[2][2][4][2], const pg8::Unit& u, int wr, int wc, int fr, int fq) const {
        const int pn = u.pn, row0 = u.pm * 256 + wr * 64 + fr;
        if (pn < 2 || (pn >= 4 && pn < 8)) {
            bf16_t* dst = (bf16_t*)(ws + (pn < 2 ? WS_QH : (pn < 6 ? WS_VH : WS_GH))); const bool act = (pn < 2) || (pn >= 6);
            const int c0 = (pn & 1) * 256 + wc * 32 + fq * 8;
#pragma unroll
            for (int ai = 0; ai < 2; ++ai)
#pragma unroll
                for (int m = 0; m < 4; ++m) { const int row = row0 + ai * 128 + m * 16;
#pragma unroll
                    for (int bj = 0; bj < 2; ++bj) { f32x4 v0 = acc[ai][bj][m][0], v1 = acc[ai][bj][m][1];
                        if (act) {
#pragma unroll
                            for (int i = 0; i < 4; ++i) { v0[i] = siluf_(v0[i]); v1[i] = siluf_(v1[i]); } }
                        *(u32x4*)(dst + (size_t)row * 512 + c0 + bj * 128) = pack8(v0, v1); } }
        } else if (pn < 4) {
            const int c0 = (pn & 1) * 256 + wc * 32 + fq * 8;
            f32x4 lbv[2][2]; const float* lb = (const float*)(ws + WS_LB); bf16_t* LF = (bf16_t*)(ws + WS_LF);
#pragma unroll
            for (int bj = 0; bj < 2; ++bj) { lbv[bj][0] = *(const f32x4*)(lb + c0 + bj * 128); lbv[bj][1] = *(const f32x4*)(lb + c0 + bj * 128 + 4); }
#pragma unroll
            for (int ai = 0; ai < 2; ++ai)
#pragma unroll
                for (int m = 0; m < 4; ++m) { const int row = row0 + ai * 128 + m * 16;
#pragma unroll
                    for (int bj = 0; bj < 2; ++bj) { f32x4 o[2];
#pragma unroll
                        for (int n = 0; n < 2; ++n) { const f32x4 v = acc[ai][bj][m][n];
#pragma unroll
                            for (int i = 0; i < 4; ++i) { const float l = lbv[bj][n][i]; o[n][i] = __log2f(l + (1.0f - l) * sigmoidf_(v[i]));     } }
                        *(u32x4*)(LF + (size_t)row * 512 + c0 + bj * 128) = (u32x4){pk_f16(o[0][0], o[0][1]), pk_f16(o[0][2], o[0][3]), pk_f16(o[1][0], o[1][1]), pk_f16(o[1][2], o[1][3])}; } }
        } else if (pn < 10) {
            const int d_lo = (wc & 1) * 16 + fq * 4;
            const int d_w = (wc & 1) * 16 + ((fq & 1) ? 32 + (fq - 1) * 4 : fq * 4);
#pragma unroll
            for (int ai = 0; ai < 2; ++ai) {
                f32x4 cs[4][2];
#pragma unroll
                for (int m = 0; m < 4; ++m) { const float* rp = (const float*)(ws + WS_ROPE) + ((size_t)row_pos(row0 + ai * 128 + m * 16) * 32 + d_lo) * 2; cs[m][0] = *(const f32x4*)rp; cs[m][1] = *(const f32x4*)(rp + 4); }
#pragma unroll
                for (int m = 0; m < 4; ++m) { const int row = row0 + ai * 128 + m * 16;
#pragma unroll
                    for (int bj = 0; bj < 2; ++bj) { f32x4 o1, o2; rope4(acc[ai][bj][m][0], acc[ai][bj][m][1], cs[m][0], cs[m][1], o1, o2); o1 = o1 * QSCALE; o2 = o2 * QSCALE;
                        const u32x2 p1 = pack4(o1), p2 = pack4(o2);
                        const auto sx = __builtin_amdgcn_permlane16_swap(p1.x, p2.x, false, false), sy = __builtin_amdgcn_permlane16_swap(p1.y, p2.y, false, false);
                        bf16_t* p = (bf16_t*)(ws + WS_AQ) + (size_t)row * 512 + (pn - 8) * 256 + (bj * 2 + (wc >> 1)) * 64 + d_w;
                        *(u32x4*)p = (u32x4){sx[0], sy[0], sx[1], sy[1]}; } } }
        } else {
            const int d_lo = (wc & 1) * 16 + fq * 4, g = wc >> 1;
#pragma unroll
            for (int ai = 0; ai < 2; ++ai) {
                f32x4 cs[4][2];
#pragma unroll
                for (int m = 0; m < 4; ++m) { const float* rp = (const float*)(ws + WS_ROPE) + ((size_t)row_pos(row0 + ai * 128 + m * 16) * 32 + d_lo) * 2; cs[m][0] = *(const f32x4*)rp; cs[m][1] = *(const f32x4*)(rp + 4); }
#pragma unroll
                for (int m = 0; m < 4; ++m) { const int row = row0 + ai * 128 + m * 16;
                    f32x4 o1, o2; rope4(acc[ai][0][m][0], acc[ai][0][m][1], cs[m][0], cs[m][1], o1, o2);
                    bf16_t* p = (bf16_t*)(ws + WS_AK) + (size_t)row * 128 + g * 64 + d_lo;
                    *(u32x2*)p = pack4(o1); *(u32x2*)(p + 32) = pack4(o2);
                    const int c = wc * 32 + fq * 8;
                    *(u32x4*)((bf16_t*)(ws + WS_AV) + (size_t)row * 128 + c) = pack8(acc[ai][1][m][0], acc[ai][1][m][1]);
} }
        }
    }
};

struct EpiOut {
    bf16_t* HB; float* SS; const float* irs; const float* ginv;
    __device__ __forceinline__ void operator()(const f32x4 (&acc)[2][2][4][2], const pg8::Unit& u, int wr, int wc, int fr, int fq) const {
        const int row0 = u.pm * 256 + wr * 64 + fr, c0 = u.pn * 256 + wc * 32 + fq * 8;
        float irv[8];
#pragma unroll
        for (int i = 0; i < 8; ++i) irv[i] = irs[row0 + (i >> 2) * 128 + (i & 3) * 16];
        f32x4 gi[2][2];
#pragma unroll
        for (int bj = 0; bj < 2; ++bj) { gi[bj][0] = *(const f32x4*)(ginv + c0 + bj * 128); gi[bj][1] = *(const f32x4*)(ginv + c0 + bj * 128 + 4); }
#pragma unroll
        for (int ai = 0; ai < 2; ++ai) {
            u32x4 xbv[2][4][2];
#pragma unroll
            for (int m = 0; m < 4; ++m)
#pragma unroll
                for (int bj = 0; bj < 2; ++bj) xbv[ai][m][bj] = *(const u32x4*)(HB + (size_t)(row0 + ai * 128 + m * 16) * DM + c0 + bj * 128);
#pragma unroll
            for (int m = 0; m < 4; ++m) { const int row = row0 + ai * 128 + m * 16; const float ir = irv[ai * 4 + m]; float ss = 0.f;
#pragma unroll
                for (int bj = 0; bj < 2; ++bj) { bf16_t* hp = HB + (size_t)row * DM + c0 + bj * 128;
                    const u32x4 xb = xbv[ai][m][bj];
                    const f32x4 x0 = (f32x4){bflo(xb.x), bfhi(xb.x), bflo(xb.y), bfhi(xb.y)} * gi[bj][0] * ir, x1 = (f32x4){bflo(xb.z), bfhi(xb.z), bflo(xb.w), bfhi(xb.w)} * gi[bj][1] * ir;
                    const f32x4 h0 = acc[ai][bj][m][0] + x0, h1 = acc[ai][bj][m][1] + x1;
                    *(u32x4*)hp = pack8(h0, h1);
                    ss += (h0[0] * h0[0] + h0[1] * h0[1]) + (h0[2] * h0[2] + h0[3] * h0[3]) + (h1[0] * h1[0] + h1[1] * h1[1]) + (h1[2] * h1[2] + h1[3] * h1[3]); }
                ss += __shfl_xor(ss, 16); ss += __shfl_xor(ss, 32);
                if (fq == 0) atomicAdd(SS + row, ss); }
        }
    }
};

struct EpiSwi {
    bf16_t* ACT; float* SS;
    __device__ __forceinline__ void operator()(const f32x4 (&acc)[2][2][4][2], const pg8::Unit& u, int wr, int wc, int fr, int fq) const {
        const int row0 = u.pm * 256 + wr * 64 + fr;
        const int cw = u.pn * 128 + wc * 16 + ((fq & 1) ? 64 + (fq - 1) * 4 : fq * 4);
        float ssv[8];
#pragma unroll
        for (int i = 0; i < 8; ++i) ssv[i] = __hip_atomic_load(SS + row0 + (i >> 2) * 128 + (i & 3) * 16, __ATOMIC_RELAXED, __HIP_MEMORY_SCOPE_AGENT);
#pragma unroll
        for (int ai = 0; ai < 2; ++ai)
#pragma unroll
            for (int m = 0; m < 4; ++m) { const int row = row0 + ai * 128 + m * 16;
                const float rs = rsqrtf(ssv[ai * 4 + m] * (1.0f / DM) + EPS);
                u32x2 pk[2];
#pragma unroll
                for (int bj = 0; bj < 2; ++bj) { f32x4 a;
#pragma unroll
                    for (int i = 0; i < 4; ++i) { const float gt = acc[ai][bj][m][0][i] * rs, up = acc[ai][bj][m][1][i] * rs; a[i] = siluf_(gt) * up; }
                    pk[bj] = pack4(a); }
                const auto sx = __builtin_amdgcn_permlane16_swap(pk[0].x, pk[1].x, false, false), sy = __builtin_amdgcn_permlane16_swap(pk[0].y, pk[1].y, false, false);
                *(u32x4*)(ACT + (size_t)row * DFF + cw) = (u32x4){sx[0], sy[0], sx[1], sy[1]}; }
    }
};

__device__ __forceinline__ void st_wt8(float* p, float a, float b) {
    const unsigned long long v = (unsigned long long)__builtin_bit_cast(unsigned, a) | ((unsigned long long)__builtin_bit_cast(unsigned, b) << 32);
    __hip_atomic_store((unsigned long long*)p, v, __ATOMIC_RELAXED, __HIP_MEMORY_SCOPE_AGENT);
}
template <int NR>
__device__ __forceinline__ void norm_rows(float* y0, const f32x4 (&gv)[4], int lane) {
    f32x4 a[NR][4]; float sq[NR];
#pragma unroll
    for (int r = 0; r < NR; ++r)
#pragma unroll
        for (int j = 0; j < 4; ++j) a[r][j] = *(const f32x4*)(y0 + (size_t)r * DM + 4 * lane + 256 * j);
#pragma unroll
    for (int r = 0; r < NR; ++r) { float q = 0.f;
#pragma unroll
        for (int j = 0; j < 4; ++j) q += (a[r][j][0] * a[r][j][0] + a[r][j][1] * a[r][j][1]) + (a[r][j][2] * a[r][j][2] + a[r][j][3] * a[r][j][3]);
        sq[r] = rsqrtf(wave_sum(q) * (1.0f / DM) + EPS); }
#pragma unroll
    for (int r = 0; r < NR; ++r)
#pragma unroll
        for (int j = 0; j < 4; ++j) *(f32x4*)(y0 + (size_t)r * DM + 4 * lane + 256 * j) = a[r][j] * sq[r] * gv[j];
}
struct EpiDown {
    float* Y; const bf16_t* HB; unsigned* cnt; const float* fnorm; float* xbuf; LAS float* scr; int fused;
    __device__ __forceinline__ void operator()(const f32x4 (&acc)[2][2][4][2], const pg8::Unit& u, int wr, int wc, int fr, int fq) const {
        const int row0 = u.pm * 256 + wr * 64 + fr, c0 = u.pn * 256 + wc * 32 + fq * 8;
        if (u.pm >= 256) {
#pragma unroll
            for (int ai = 0; ai < 2; ++ai)
#pragma unroll
                for (int m = 0; m < 4; ++m) { const int row = row0 + ai * 128 + m * 16;
#pragma unroll
                    for (int bj = 0; bj < 2; ++bj) { float* yp = Y + (size_t)row * DM + c0 + bj * 128;
#pragma unroll
                        for (int i = 0; i < 4; ++i) { atomicAdd(yp + i, acc[ai][bj][m][0][i]); atomicAdd(yp + 4 + i, acc[ai][bj][m][1][i]); } } }
            return;
        }
        if (!fused) {
#pragma unroll
            for (int ai = 0; ai < 2; ++ai) {
                u32x4 hbv[4][2];
#pragma unroll
                for (int m = 0; m < 4; ++m)
#pragma unroll
                    for (int bj = 0; bj < 2; ++bj) hbv[m][bj] = *(const u32x4*)(HB + (size_t)(row0 + ai * 128 + m * 16) * DM + c0 + bj * 128);
#pragma unroll
                for (int m = 0; m < 4; ++m) { const int row = row0 + ai * 128 + m * 16;
#pragma unroll
                    for (int bj = 0; bj < 2; ++bj) { const u32x4 hb = hbv[m][bj];
                        const f32x4 h0 = acc[ai][bj][m][0] + (f32x4){bflo(hb.x), bfhi(hb.x), bflo(hb.y), bfhi(hb.y)}, h1 = acc[ai][bj][m][1] + (f32x4){bflo(hb.z), bfhi(hb.z), bflo(hb.w), bfhi(hb.w)};
                        *(u32x4*)((bf16_t*)HB + (size_t)row * DM + c0 + bj * 128) = pack8(h0, h1); } }
            }
            return;
        }
#pragma unroll
        for (int ai = 0; ai < 2; ++ai) {
            u32x4 hbv[4][2];
#pragma unroll
            for (int m = 0; m < 4; ++m)
#pragma unroll
                for (int bj = 0; bj < 2; ++bj) hbv[m][bj] = *(const u32x4*)((const char*)HB + ((unsigned)(row0 + ai * 128 + m * 16) * (unsigned)(DM * 2) + (unsigned)(c0 + bj * 128) * 2u));
#pragma unroll
            for (int m = 0; m < 4; ++m) { float q = 0.f;
#pragma unroll
                for (int bj = 0; bj < 2; ++bj) { const u32x4 hb = hbv[m][bj];
                    const f32x4 h0 = acc[ai][bj][m][0] + (f32x4){bflo(hb.x), bfhi(hb.x), bflo(hb.y), bfhi(hb.y)}, h1 = acc[ai][bj][m][1] + (f32x4){bflo(hb.z), bfhi(hb.z), bflo(hb.w), bfhi(hb.w)};
                    q += (h0[0] * h0[0] + h0[1] * h0[1]) + (h0[2] * h0[2] + h0[3] * h0[3]) + (h1[0] * h1[0] + h1[1] * h1[1]) + (h1[2] * h1[2] + h1[3] * h1[3]); }
                q += __shfl_xor(q, 16); q += __shfl_xor(q, 32);
                if (fq == 0) scr[(ai * 128 + wr * 64 + m * 16 + fr) * 4 + wc] = q; }
        }
        asm volatile("s_waitcnt lgkmcnt(0)" ::: "memory");
        __builtin_amdgcn_s_barrier();
        if (threadIdx.x < 256) { const f32x4 p4 = *(const LAS f32x4*)(scr + threadIdx.x * 4);
            __hip_atomic_store(xbuf + ((size_t)u.pm * 256 + threadIdx.x) * 4 + u.pn, (p4[0] + p4[1]) + (p4[2] + p4[3]), __ATOMIC_RELAXED, __HIP_MEMORY_SCOPE_AGENT); }
        asm volatile("s_waitcnt vmcnt(0)" ::: "memory");
        __builtin_amdgcn_s_barrier();
        if (threadIdx.x == 0) {
            __hip_atomic_fetch_add(cnt + u.pm, 1u, __ATOMIC_RELAXED, __HIP_MEMORY_SCOPE_AGENT);
            unsigned spins = 0;
            while (__hip_atomic_load(cnt + u.pm, __ATOMIC_RELAXED, __HIP_MEMORY_SCOPE_AGENT) < 4u && ++spins < (1u << 22)) __builtin_amdgcn_s_sleep(1);
        }
        __builtin_amdgcn_s_barrier();
        if (threadIdx.x < 256) {
            const float* xp = xbuf + ((size_t)u.pm * 256 + threadIdx.x) * 4;
            const float t0 = __hip_atomic_load(xp, __ATOMIC_RELAXED, __HIP_MEMORY_SCOPE_AGENT), t1 = __hip_atomic_load(xp + 1, __ATOMIC_RELAXED, __HIP_MEMORY_SCOPE_AGENT),
                        t2 = __hip_atomic_load(xp + 2, __ATOMIC_RELAXED, __HIP_MEMORY_SCOPE_AGENT), t3 = __hip_atomic_load(xp + 3, __ATOMIC_RELAXED, __HIP_MEMORY_SCOPE_AGENT);
            scr[1024 + threadIdx.x] = rsqrtf(((t0 + t1) + (t2 + t3)) * (1.0f / DM) + EPS); }
        asm volatile("s_waitcnt lgkmcnt(0)" ::: "memory");
        __builtin_amdgcn_s_barrier();
        f32x4 gn[2][2];
#pragma unroll
        for (int bj = 0; bj < 2; ++bj) { gn[bj][0] = *(const f32x4*)(fnorm + c0 + bj * 128); gn[bj][1] = *(const f32x4*)(fnorm + c0 + bj * 128 + 4); }
#pragma unroll
        for (int ai = 0; ai < 2; ++ai) {
            u32x4 hbv[4][2];
#pragma unroll
            for (int m = 0; m < 4; ++m)
#pragma unroll
                for (int bj = 0; bj < 2; ++bj) hbv[m][bj] = *(const u32x4*)((const char*)HB + ((unsigned)(row0 + ai * 128 + m * 16) * (unsigned)(DM * 2) + (unsigned)(c0 + bj * 128) * 2u));
#pragma unroll
            for (int m = 0; m < 4; ++m) { const int row = row0 + ai * 128 + m * 16; const float r = scr[1024 + wr * 64 + fr + ai * 128 + m * 16];
#pragma unroll
                for (int bj = 0; bj < 2; ++bj) { const u32x4 hb = hbv[m][bj]; float* yp = (float*)((char*)Y + ((unsigned)row * (unsigned)(DM * 4) + (unsigned)(c0 + bj * 128) * 4u));
                    const f32x4 h0 = acc[ai][bj][m][0] + (f32x4){bflo(hb.x), bfhi(hb.x), bflo(hb.y), bfhi(hb.y)}, h1 = acc[ai][bj][m][1] + (f32x4){bflo(hb.z), bfhi(hb.z), bflo(hb.w), bfhi(hb.w)};
                    *(f32x4*)yp = h0 * r * gn[bj][0]; *(f32x4*)(yp + 4) = h1 * r * gn[bj][1]; } }
        }
    }
};

__device__ __forceinline__ int map_in(int p) {
    if (p < 2048 || p >= 2688) return p;
    const int q = p - 2048, head = q >> 6, pp = q & 63, wcp = pp >> 5, fq = (pp >> 3) & 3, n = (pp >> 2) & 1, i = pp & 3;
    return 2048 + head * 64 + n * 32 + wcp * 16 + fq * 4 + i;
}
__device__ __forceinline__ int map_ffn(int p) {
    const int G = p >> 5, fq = (p >> 3) & 3, n = (p >> 2) & 1, i = p & 3; return n * DFF + G * 16 + fq * 4 + i;
}
template <int MAP>
__device__ __forceinline__ void p0_transpose_item(const float* W, int K, int N, bf16_t* WT, const float* gain, LAS float* scr, int item, int lane) {
    const int nblk = N / 32, kb = item / nblk, nb = item % nblk, k0 = 64 * kb, n0 = 32 * nb;
    const int pc = n0 + (lane & 31); const int lc = MAP == 1 ? map_in(pc) : (MAP == 2 ? map_ffn(pc) : pc);
    float wv[32];
#pragma unroll
    for (int i = 0; i < 32; ++i) wv[i] = W[(size_t)(k0 + 2 * i + (lane >> 5)) * N + lc];
#pragma unroll
    for (int i = 0; i < 32; ++i) { const int kk = 2 * i + (lane >> 5); float w = wv[i]; if (gain) w *= gain[k0 + kk]; scr[kk * 33 + (lane & 31)] = w; }
    LDS_WAIT(); asm volatile("" ::: "memory");
    const int c = lane & 7;
#pragma unroll
    for (int j = 0; j < 4; ++j) { const int n = (lane >> 3) + 8 * j; const LAS float* s = scr + (8 * c) * 33 + n;
        u32x4 o; o.x = cvt_pk_bf16(s[0 * 33], s[1 * 33]); o.y = cvt_pk_bf16(s[2 * 33], s[3 * 33]); o.z = cvt_pk_bf16(s[4 * 33], s[5 * 33]); o.w = cvt_pk_bf16(s[6 * 33], s[7 * 33]);
        *(u32x4*)(WT + (size_t)(n0 + n) * K + k0 + 8 * c) = o; }
    LDS_WAIT(); asm volatile("" ::: "memory");
}

__device__ __forceinline__ void p0_prologue(const Params& P, LAS unsigned char* lds) {
    const int tid = threadIdx.x, lane = tid & 63, wave = tid >> 6;
    const int gw = blockIdx.x * 8 + wave, NGW = gridDim.x * 8;
    unsigned char* ws = P.ws;
    LAS float* scr = (LAS float*)(lds + wave * 16384);
    constexpr int I_IN = 16 * (NIN / 32), I_OUT = 16 * 32, I_FI = 16 * (NFF2 / 32), I_FO = (DFF / 64) * 32;
    for (int it = gw; it < I_IN + I_OUT + I_FI + I_FO; it += NGW) {
        int r = it;
        if (r < I_IN) { p0_transpose_item<1>(P.in[9], DM, NIN, (bf16_t*)(ws + WS_WIN), nullptr, scr, r, lane); continue; } r -= I_IN;
        if (r < I_OUT) { p0_transpose_item<0>(P.in[14], DM, DM, (bf16_t*)(ws + WS_WOUT), nullptr, scr, r, lane); continue; } r -= I_OUT;
        if (r < I_FI) { p0_transpose_item<2>(P.in[16], DM, NFF2, (bf16_t*)(ws + WS_WFI), P.in[15], scr, r, lane); continue; } r -= I_FI;
        p0_transpose_item<0>(P.in[17], DFF, DM, (bf16_t*)(ws + WS_WFO), nullptr, scr, r, lane);
    }
    {
        const float* g1 = P.in[8]; bf16_t* XN = (bf16_t*)(ws + WS_XN);
        f32x4 gv[4];
#pragma unroll
        for (int j = 0; j < 4; ++j) gv[j] = *(const f32x4*)(g1 + 4 * lane + 256 * j);
        for (int q4 = gw; q4 < RTOT / 4; q4 += NGW) {
            const int r0 = q4 * 4;
            if (r0 >= ROW_END) {
#pragma unroll
                for (int rr = 0; rr < 4; ++rr) { unsigned long long* o8 = (unsigned long long*)(XN + (size_t)(r0 + rr) * DM) + lane;
#pragma unroll
                    for (int j = 0; j < 4; ++j) o8[64 * j] = 0ull; }
                continue; }
            const float* src = r0 < ROW_S ? P.in[0] + (size_t)r0 * DM : (r0 < ROW_M ? P.in[1] + (size_t)(r0 - ROW_S) * DM : P.in[7] + (size_t)(r0 - ROW_M) * DM);
            f32x4 v[4][4]; float sq[4];
#pragma unroll
            for (int rr = 0; rr < 4; ++rr)
#pragma unroll
                for (int j = 0; j < 4; ++j) v[rr][j] = *(const f32x4*)(src + (size_t)rr * DM + 4 * lane + 256 * j);
#pragma unroll
            for (int rr = 0; rr < 4; ++rr) { float s_ = 0.f;
#pragma unroll
                for (int j = 0; j < 4; ++j) s_ += (v[rr][j][0] * v[rr][j][0] + v[rr][j][1] * v[rr][j][1]) + (v[rr][j][2] * v[rr][j][2] + v[rr][j][3] * v[rr][j][3]);
                const float ms_ = wave_sum(s_) * (1.0f / DM) + EPS; sq[rr] = rsqrtf(ms_); if (lane == 0) ((float*)(ws + WS_SS2))[r0 + rr] = sqrtf(ms_); }
#pragma unroll
            for (int rr = 0; rr < 4; ++rr) { unsigned long long* o8 = (unsigned long long*)(XN + (size_t)(r0 + rr) * DM) + lane;
#pragma unroll
                for (int j = 0; j < 4; ++j) { const f32x4 y = v[rr][j] * sq[rr] * gv[j];
                    o8[64 * j] = (unsigned long long)cvt_pk_bf16(y[0], y[1]) | ((unsigned long long)cvt_pk_bf16(y[2], y[3]) << 32); } }
        }
    }
    {
        const int gt = blockIdx.x * 512 + tid, NGT = gridDim.x * 512;
        float* lb = (float*)(ws + WS_LB); float* rope = (float*)(ws + WS_ROPE); float* ss1 = (float*)(ws + WS_SS1);
        if (gt < 512) { const float p0 = P.in[10][gt], p1 = P.in[10][512 + gt]; lb[gt] = 1.0f / (1.0f + expf(p1 - p0)); }
        if (gt < 320) { ((unsigned*)(ws + WS_CTL))[gt] = 0u; }
        if (gt < DM) ((float*)(ws + WS_GINV))[gt] = 1.0f / P.in[8][gt];
        for (int i = gt; i < NPOS * 32; i += NGT) { const int pos = i >> 5, d = i & 31;
            const double inv = exp(-(double)d * (9.210340371976184 / 32.0)), ang = (double)pos * inv;
            rope[2 * i] = (float)cos(ang); rope[2 * i + 1] = (float)sin(ang); }
        for (int i = gt; i < RTOT; i += NGT) ss1[i] = 0.f;
    }
}

constexpr int HG_QD = 0, HG_KD = 17408, HG_QB = 34816, HG_KLT = 52224, HG_VT = 70656, HG_ST = 89088, HG_AM = 123904, HG_SEG = 133120, HG_DL = 137216, HG_RSS = 137728;
constexpr int PK = 272  , PT = 144  ;

__device__ __forceinline__ void hgrn_unit(const Params& P, LAS unsigned char* lds, int kind, int b, int h) {
    const int tid = threadIdx.x, lane = tid & 63, w = __builtin_amdgcn_readfirstlane(tid >> 6), fr = lane & 15, fq = lane >> 4;
    unsigned char* ws = P.ws;
    const bf16_t* QH = (const bf16_t*)(ws + WS_QH); const bf16_t* LF = (const bf16_t*)(ws + WS_LF); const bf16_t* VH = (const bf16_t*)(ws + WS_VH);
    const bf16_t* GH = (const bf16_t*)(ws + WS_GH); bf16_t* MIX = (bf16_t*)(ws + WS_MIX); const float* hgn = P.in[11];
    const int k = tid & 127, seg = tid >> 7;
    const int kp = w & 3, vh = w >> 2;
    f32x4 sacc[2][4];
    if (kind == 0) {
#pragma unroll
        for (int a = 0; a < 2; ++a)
#pragma unroll
            for (int c = 0; c < 4; ++c) sacc[a][c] = (f32x4){0.f, 0.f, 0.f, 0.f};
    } else {
        const float* S0 = P.in[6] + (size_t)(b * 4 + h) * 16384;
#pragma unroll
        for (int a = 0; a < 2; ++a)
#pragma unroll
            for (int c = 0; c < 4; ++c)
#pragma unroll
                for (int j = 0; j < 4; ++j) sacc[a][c][j] = S0[(size_t)((kp * 2 + a) * 16 + fq * 4 + j) * 128 + (vh * 4 + c) * 16 + fr];
    }
    f32x4 gnv[4];
#pragma unroll
    for (int c = 0; c < 4; ++c) gnv[c] = *(const f32x4*)(hgn + h * 128 + (vh * 4 + c) * 16 + fq * 4);
    const int nchunks = kind == 0 ? 33 : 1;
#define BAR_LDS() do { asm volatile("s_waitcnt lgkmcnt(0)" ::: "memory"); __builtin_amdgcn_s_barrier(); asm volatile("" ::: "memory"); } while (0)
#define HG_DESC(ci_, row0_, nvalid_, wout_) do { if (kind == 0) { if ((ci_) == 0) { row0_ = ROW_M; nvalid_ = NMETA; wout_ = false; } else { row0_ = b * SEQ + ((ci_) - 1) * 64; nvalid_ = 64; wout_ = true; } } \
        else { row0_ = ROW_S + b * DSEQ; nvalid_ = DSEQ; wout_ = true; } } while (0)
#define HG_LOAD(ci_) do { int r0_, nv_; bool wo_; HG_DESC(ci_, r0_, nv_, wo_); (void)wo_; \
        if (w * 8 < nv_) { const size_t ro_ = (size_t)(r0_ + w * 8) * 512 + h * 128; const bf16_t* lp_ = LF + ro_; const bf16_t* qp_ = QH + ro_; const bf16_t* vp_ = VH + ro_; \
            _Pragma("unroll") for (int i = 0; i < 8; ++i) { lfr[i] = *(const unsigned*)(lp_ + i * 512 + 2 * lane); qraw[i] = *(const unsigned*)(qp_ + i * 512 + 2 * lane); vraw[i] = *(const unsigned*)(vp_ + i * 512 + 2 * lane); } } \
        else { _Pragma("unroll") for (int i = 0; i < 8; ++i) { lfr[i] = 0u; qraw[i] = 0u; vraw[i] = 0u; } } } while (0)
    unsigned lfr[8], qraw[8], vraw[8];
    f32x4 oa[4]; u32x2 gg[4]; int prow0 = 0, pnvalid = 0; bool pwout = false;
#pragma unroll
    for (int c = 0; c < 4; ++c) { oa[c] = (f32x4){0.f, 0.f, 0.f, 0.f}; gg[c] = (u32x2){0u, 0u}; }
#define HG_READOUT() do { if (pwout) { const int t = (w & 3) * 16 + fr; \
            if (t < pnvalid) { const float tot = ((LAS float*)(lds + HG_RSS))[t * 2] + ((LAS float*)(lds + HG_RSS))[t * 2 + 1]; \
                const float rs = rsqrtf(tot * (1.0f / 128.0f) + EPS); const size_t row = (size_t)(prow0 + t); \
                _Pragma("unroll") for (int c = 0; c < 4; ++c) { const int v0 = h * 128 + (vh * 4 + c) * 16 + fq * 4; const f32x4 gn = gnv[c]; \
                    f32x4 y; y[0] = oa[c][0] * rs * gn[0] * bflo(gg[c].x); y[1] = oa[c][1] * rs * gn[1] * bfhi(gg[c].x); \
                    y[2] = oa[c][2] * rs * gn[2] * bflo(gg[c].y); y[3] = oa[c][3] * rs * gn[3] * bfhi(gg[c].y); \
                    *(u32x2*)(MIX + row * DM + v0) = pack4(y); } } } } while (0)
    HG_LOAD(0);
    for (int ci = 0; ci < nchunks; ++ci) {
        int row0, nvalid; bool wout; HG_DESC(ci, row0, nvalid, wout);
        f32x2 lf[8]; unsigned qr[8], vr[8];
#pragma unroll
        for (int i = 0; i < 8; ++i) { const f16x2 hh = __builtin_bit_cast(f16x2, lfr[i]); lf[i].x = (float)hh.x; lf[i].y = (float)hh.y; qr[i] = qraw[i]; vr[i] = vraw[i]; }
        if (ci + 1 < nchunks) HG_LOAD(ci + 1);
        f32x2 cs[8]; { f32x2 a = (f32x2){0.f, 0.f};
#pragma unroll
            for (int i = 0; i < 8; ++i) { a = a + lf[i]; cs[i] = a; } }
        *(LAS f32x2*)(lds + HG_SEG + (w * 128 + 2 * lane) * 4) = cs[7];
        BAR_LDS();
        f32x2 pre = (f32x2){0.f, 0.f}, bm = (f32x2){0.f, 0.f}, bL;
        { f32x2 hi = (f32x2){0.f, 0.f};
#pragma unroll
            for (int sgi = 0; sgi < 8; ++sgi) { const f32x2 sv = *(const LAS f32x2*)(lds + HG_SEG + (sgi * 128 + 2 * lane) * 4);
                if (sgi < w) pre = pre + sv;
                if (sgi < 4) bm = bm + sv; else hi = hi + sv; }
            bL = bm + hi; }
        f32x2 em, elm; em.x = __builtin_amdgcn_exp2f(bm.x); em.y = __builtin_amdgcn_exp2f(bm.y); elm.x = __builtin_amdgcn_exp2f(bL.x - bm.x); elm.y = __builtin_amdgcn_exp2f(bL.y - bm.y);
        if (w == 0) { f32x2 dl; dl.x = __builtin_amdgcn_exp2f(bL.x); dl.y = __builtin_amdgcn_exp2f(bL.y); *(LAS f32x2*)(lds + HG_DL + 2 * lane * 4) = dl; }
        f32x2 klv[8];
#pragma unroll
        for (int i = 0; i < 8; ++i) { const int t = w * 8 + i;
            const f32x2 d = (pre + cs[i]) - bm;
            f32x2 e1, r1, kk, q;
            e1.x = __builtin_amdgcn_exp2f(d.x); e1.y = __builtin_amdgcn_exp2f(d.y); r1.x = __builtin_amdgcn_exp2f(-d.x); r1.y = __builtin_amdgcn_exp2f(-d.y);
            kk.x = 1.0f - __builtin_amdgcn_exp2f(lf[i].x); kk.y = 1.0f - __builtin_amdgcn_exp2f(lf[i].y);
            q.x = bflo(qr[i]); q.y = bfhi(qr[i]);
            const f32x2 qd = q * e1, kd = kk * r1, qb = qd * em; klv[i] = kd * elm;
            *(LAS unsigned*)(lds + HG_QD + t * PK + lane * 4) = cvt_pk_bf16(qd.x, qd.y);
            *(LAS unsigned*)(lds + HG_KD + t * PK + lane * 4) = cvt_pk_bf16(kd.x, kd.y);
            *(LAS unsigned*)(lds + HG_QB + t * PK + lane * 4) = cvt_pk_bf16(qb.x, qb.y); }
        {
            u32x4 k0, k1, v0, v1;
            k0.x = cvt_pk_bf16(klv[0].x, klv[1].x); k0.y = cvt_pk_bf16(klv[2].x, klv[3].x); k0.z = cvt_pk_bf16(klv[4].x, klv[5].x); k0.w = cvt_pk_bf16(klv[6].x, klv[7].x);
            k1.x = cvt_pk_bf16(klv[0].y, klv[1].y); k1.y = cvt_pk_bf16(klv[2].y, klv[3].y); k1.z = cvt_pk_bf16(klv[4].y, klv[5].y); k1.w = cvt_pk_bf16(klv[6].y, klv[7].y);
            v0.x = __builtin_amdgcn_perm(vr[1], vr[0], 0x05040100u); v0.y = __builtin_amdgcn_perm(vr[3], vr[2], 0x05040100u); v0.z = __builtin_amdgcn_perm(vr[5], vr[4], 0x05040100u); v0.w = __builtin_amdgcn_perm(vr[7], vr[6], 0x05040100u);
            v1.x = __builtin_amdgcn_perm(vr[1], vr[0], 0x07060302u); v1.y = __builtin_amdgcn_perm(vr[3], vr[2], 0x07060302u); v1.z = __builtin_amdgcn_perm(vr[5], vr[4], 0x07060302u); v1.w = __builtin_amdgcn_perm(vr[7], vr[6], 0x07060302u);
            *(LAS u32x4*)(lds + HG_KLT + (2 * lane) * PT + w * 16) = k0; *(LAS u32x4*)(lds + HG_KLT + (2 * lane + 1) * PT + w * 16) = k1;
            *(LAS u32x4*)(lds + HG_VT + (2 * lane) * PT + w * 16) = v0; *(LAS u32x4*)(lds + HG_VT + (2 * lane + 1) * PT + w * 16) = v1;
        }
        HG_READOUT();
        prow0 = row0; pnvalid = nvalid; pwout = wout;
        { const int t = (w & 3) * 16 + fr;
#pragma unroll
            for (int c = 0; c < 4; ++c) gg[c] = *(const u32x2*)(GH + (size_t)(row0 + t) * 512 + h * 128 + (vh * 4 + c) * 16 + fq * 4); }
#pragma unroll
        for (int a = 0; a < 2; ++a)
#pragma unroll
            for (int c = 0; c < 4; ++c) { const int kk0 = (kp * 2 + a) * 16 + fq * 4, v = (vh * 4 + c) * 16 + fr;
                *(LAS u32x2*)(lds + HG_ST + v * PK + kk0 * 2) = pack4(sacc[a][c]); }
        BAR_LDS();
        {
            const int st = w & 3, tt0 = (w >> 2) * 2;
            f32x4 aa[2] = {(f32x4){0.f, 0.f, 0.f, 0.f}, (f32x4){0.f, 0.f, 0.f, 0.f}};
#pragma unroll
            for (int kk = 0; kk < 4; ++kk) { const bf16x8 af = *(const LAS bf16x8*)(lds + HG_KD + (st * 16 + fr) * PK + kk * 64 + fq * 16);
#pragma unroll
                for (int e = 0; e < 2; ++e) { const bf16x8 bfq = *(const LAS bf16x8*)(lds + HG_QD + ((tt0 + e) * 16 + fr) * PK + kk * 64 + fq * 16);
                    aa[e] = __builtin_amdgcn_mfma_f32_16x16x32_bf16(af, bfq, aa[e], 0, 0, 0); } }
#pragma unroll
            for (int e = 0; e < 2; ++e) { const int t = (tt0 + e) * 16 + fr, sb = st * 16 + fq * 4; f32x4 m;
#pragma unroll
                for (int j = 0; j < 4; ++j) m[j] = (sb + j <= t) ? aa[e][j] : 0.f;
                *(LAS u32x2*)(lds + HG_AM + t * PT + sb * 2) = pack4(m); }
        }
        BAR_LDS();
        const int tt = w & 3;
        {
#pragma unroll
            for (int c = 0; c < 4; ++c) oa[c] = (f32x4){0.f, 0.f, 0.f, 0.f};
#pragma unroll
            for (int kk = 0; kk < 4; ++kk) { const bf16x8 bq = *(const LAS bf16x8*)(lds + HG_QB + (tt * 16 + fr) * PK + kk * 64 + fq * 16);
#pragma unroll
                for (int c = 0; c < 4; ++c) { const bf16x8 af = *(const LAS bf16x8*)(lds + HG_ST + ((vh * 4 + c) * 16 + fr) * PK + kk * 64 + fq * 16);
                    oa[c] = __builtin_amdgcn_mfma_f32_16x16x32_bf16(af, bq, oa[c], 0, 0, 0); } }
#pragma unroll
            for (int ss = 0; ss < 2; ++ss) { const bf16x8 bq = *(const LAS bf16x8*)(lds + HG_AM + (tt * 16 + fr) * PT + ss * 64 + fq * 16);
#pragma unroll
                for (int c = 0; c < 4; ++c) { const bf16x8 af = *(const LAS bf16x8*)(lds + HG_VT + ((vh * 4 + c) * 16 + fr) * PT + ss * 64 + fq * 16);
                    oa[c] = __builtin_amdgcn_mfma_f32_16x16x32_bf16(af, bq, oa[c], 0, 0, 0); } }
            float q = 0.f;
#pragma unroll
            for (int c = 0; c < 4; ++c) q += (oa[c][0] * oa[c][0] + oa[c][1] * oa[c][1]) + (oa[c][2] * oa[c][2] + oa[c][3] * oa[c][3]);
            q += __shfl_xor(q, 16); q += __shfl_xor(q, 32);
            if (fq == 0) ((LAS float*)(lds + HG_RSS))[(tt * 16 + fr) * 2 + vh] = q;
        }
        {
#pragma unroll
            for (int a = 0; a < 2; ++a) { const f32x4 dl = *(const LAS f32x4*)(lds + HG_DL + ((kp * 2 + a) * 16 + fq * 4) * 4);
#pragma unroll
                for (int c = 0; c < 4; ++c) sacc[a][c] = sacc[a][c] * dl; }
#pragma unroll
            for (int t2 = 0; t2 < 2; ++t2) {
                bf16x8 af[2], bv[4];
#pragma unroll
                for (int a = 0; a < 2; ++a) af[a] = *(const LAS bf16x8*)(lds + HG_KLT + ((kp * 2 + a) * 16 + fr) * PT + t2 * 64 + fq * 16);
#pragma unroll
                for (int c = 0; c < 4; ++c) bv[c] = *(const LAS bf16x8*)(lds + HG_VT + ((vh * 4 + c) * 16 + fr) * PT + t2 * 64 + fq * 16);
#pragma unroll
                for (int a = 0; a < 2; ++a)
#pragma unroll
                    for (int c = 0; c < 4; ++c) sacc[a][c] = __builtin_amdgcn_mfma_f32_16x16x32_bf16(af[a], bv[c], sacc[a][c], 0, 0, 0);
            }
        }
    }
    BAR_LDS();
    HG_READOUT();
    float* so = P.out + (kind == 0 ? OFF_PST : OFF_SST) + (size_t)(b * 4 + h) * 16384;
#pragma unroll
    for (int a = 0; a < 2; ++a)
#pragma unroll
        for (int c = 0; c < 4; ++c)
#pragma unroll
            for (int j = 0; j < 4; ++j) so[(size_t)((kp * 2 + a) * 16 + fq * 4 + j) * 128 + (vh * 4 + c) * 16 + fr] = sacc[a][c][j];
    __syncthreads();
}

constexpr int AT_K = 0, AT_V = 56576;
constexpr int PKA = 272, PVA = 472;

__device__ __forceinline__ void attn_unit(const Params& P, LAS unsigned char* lds, int kind, int b, int c) {
    const int tid = threadIdx.x, lane = tid & 63, w = __builtin_amdgcn_readfirstlane(tid >> 6), fr = lane & 15, fq = lane >> 4;
    unsigned char* ws = P.ws;
    const bf16_t* AQ = (const bf16_t*)(ws + WS_AQ); const bf16_t* AK = (const bf16_t*)(ws + WS_AK); const bf16_t* AV = (const bf16_t*)(ws + WS_AV);
    bf16_t* MIX = (bf16_t*)(ws + WS_MIX);
    const int nqt = kind == 0 ? 2 : 1;
    const int tl = fr >> 2, hr = fr & 3;
    bf16x8 qf[2][2][2];
#pragma unroll
    for (int qt = 0; qt < 2; ++qt) { const int t = kind == 0 ? w * 8 + qt * 4 + tl : w * 4 + tl;
        const size_t row = kind == 0 ? (size_t)b * SEQ + c * 64 + t : (size_t)ROW_S + b * DSEQ + t;
#pragma unroll
        for (int g = 0; g < 2; ++g)
#pragma unroll
            for (int dd = 0; dd < 2; ++dd) qf[qt][g][dd] = (qt < nqt) ? *(const bf16x8*)(AQ + row * 512 + (g * 4 + hr) * 64 + dd * 32 + fq * 8) : (bf16x8){0, 0, 0, 0, 0, 0, 0, 0}; }
    __syncthreads();
    {
        u32x4 kq[7], vq[7];
#pragma unroll
        for (int it = 0; it < 7; ++it) {
            kq[it] = (u32x4){0u, 0u, 0u, 0u}; vq[it] = (u32x4){0u, 0u, 0u, 0u};
            const int idx = tid + it * 512, jk = idx >> 4, pck = idx & 15;
            const int jv = it * 32 + (lane & 31), pcv = w * 2 + (lane >> 5);
            if (kind == 0) {
                int rk = -1, rv = -1;
                if (jk < 16) rk = ROW_M + jk; else if (jk < 208) { const int sq = (c - 2) * 64 + (jk - 16); if (sq >= 0) rk = b * SEQ + sq; }
                if (jv < 16) rv = ROW_M + jv; else if (jv < 208) { const int sq = (c - 2) * 64 + (jv - 16); if (sq >= 0) rv = b * SEQ + sq; }
                const u32x4 kl = *(const u32x4*)(AK + (size_t)(rk >= 0 ? rk : 0) * 128 + pck * 8), vl = *(const u32x4*)(AV + (size_t)(rv >= 0 ? rv : 0) * 128 + pcv * 8);
                if (rk >= 0) kq[it] = kl;
                if (rv >= 0) vq[it] = vl;
            } else {
                if (jk < 144) { const float* kp_ = jk < 16 ? P.in[2] + (size_t)(b * 16 + jk) * 128 : P.in[4] + (size_t)(b * 128 + jk - 16) * 128;
                    kq[it] = pack8(*(const f32x4*)(kp_ + pck * 8), *(const f32x4*)(kp_ + pck * 8 + 4)); }
                else if (jk < 176) kq[it] = *(const u32x4*)(AK + (size_t)(ROW_S + b * DSEQ + (jk - 144)) * 128 + pck * 8);
                if (jv < 144) { const float* vp_ = jv < 16 ? P.in[3] + (size_t)(b * 16 + jv) * 128 : P.in[5] + (size_t)(b * 128 + jv - 16) * 128;
                    vq[it] = pack8(*(const f32x4*)(vp_ + pcv * 8), *(const f32x4*)(vp_ + pcv * 8 + 4)); }
                else if (jv < 176) vq[it] = *(const u32x4*)(AV + (size_t)(ROW_S + b * DSEQ + (jv - 144)) * 128 + pcv * 8);
            }
        }
#pragma unroll
        for (int it = 0; it < 7; ++it) {
            const int idx = tid + it * 512, jk = idx >> 4, pck = idx & 15;
            const int jv = it * 32 + (lane & 31), pcv = w * 2 + (lane >> 5);
            if (jk < 208) *(LAS u32x4*)(lds + AT_K + jk * PKA + pck * 16) = kq[it];
#pragma unroll
            for (int e = 0; e < 4; ++e) { const unsigned u = vq[it][e];
                *(LAS bf16_t*)(lds + AT_V + (pcv * 8 + 2 * e) * PVA + jv * 2) = (bf16_t)(u & 0xffffu);
                *(LAS bf16_t*)(lds + AT_V + (pcv * 8 + 2 * e + 1) * PVA + jv * 2) = (bf16_t)(u >> 16); }
        }
    }
    __syncthreads();
    unsigned vmask;
    if (kind == 0) vmask = 0x1u | (c >= 2 ? 0x1eu : 0u) | (c >= 1 ? 0x1e0u : 0u) | 0x1e00u; else vmask = 0x7ffu;
    const float* sinks = P.in[12]; const float* an = P.in[13];
    for (int qt = 0; qt < nqt; ++qt) {
        const int t = kind == 0 ? w * 8 + qt * 4 + tl : w * 4 + tl;
        const size_t row = kind == 0 ? (size_t)b * SEQ + c * 64 + t : (size_t)ROW_S + b * DSEQ + t;
        f32x4 oacc[2][4];
#pragma unroll
        for (int g = 0; g < 2; ++g) {
            bf16x8 qsel[2];
#pragma unroll
            for (int dd = 0; dd < 2; ++dd) qsel[dd] = qt == 0 ? qf[0][g][dd] : qf[1][g][dd];
            f32x4 sa[13];
#pragma unroll
            for (int kt = 0; kt < 13; ++kt) { sa[kt] = (f32x4){0.f, 0.f, 0.f, 0.f};
#pragma unroll
                for (int dd = 0; dd < 2; ++dd) { const bf16x8 kf = *(const LAS bf16x8*)(lds + AT_K + (kt * 16 + fr) * PKA + g * 128 + dd * 64 + fq * 16);
                    sa[kt] = __builtin_amdgcn_mfma_f32_16x16x32_bf16(kf, qsel[dd], sa[kt], 0, 0, 0); } }
            const float sink = sinks[g * 4 + hr] * LOG2E;
            float mx = sink;
#pragma unroll
            for (int kt = 0; kt < 13; ++kt) { const float nb = ((vmask >> kt) & 1u) ? 0.f : -1e30f;
                sa[kt] = sa[kt] + nb;
                mx = fmaxf(fmaxf(mx, fmaxf(sa[kt][0], sa[kt][1])), fmaxf(sa[kt][2], sa[kt][3])); }
            mx = fmaxf(mx, __shfl_xor(mx, 16)); mx = fmaxf(mx, __shfl_xor(mx, 32));
            float sum = 0.f;
#pragma unroll
            for (int kt = 0; kt < 13; ++kt) {
#pragma unroll
                for (int j = 0; j < 4; ++j) sa[kt][j] = __builtin_amdgcn_exp2f(sa[kt][j] - mx);
                sum += (sa[kt][0] + sa[kt][1]) + (sa[kt][2] + sa[kt][3]);
            }
            sum += __shfl_xor(sum, 16); sum += __shfl_xor(sum, 32);
            const float inv = 1.0f / (sum + __builtin_amdgcn_exp2f(sink - mx));
            bf16x8 pb[7];
#pragma unroll
            for (int kp = 0; kp < 7; ++kp) { const f32x4 p0 = sa[2 * kp], p1 = (2 * kp + 1 < 13) ? sa[(2 * kp + 1 < 13) ? 2 * kp + 1 : 0] : (f32x4){0.f, 0.f, 0.f, 0.f};
                const u32x4 u = pack8(p0, p1); pb[kp] = __builtin_bit_cast(bf16x8, u); }
#pragma unroll
            for (int dt = 0; dt < 4; ++dt) { oacc[g][dt] = (f32x4){0.f, 0.f, 0.f, 0.f};
#pragma unroll
                for (int kp = 0; kp < 7; ++kp) {
                    const s16x4 v0 = *(const LAS s16x4*)(lds + AT_V + (g * 64 + dt * 16 + fr) * PVA + (2 * kp) * 32 + fq * 8);
                    const s16x4 v1 = *(const LAS s16x4*)(lds + AT_V + (g * 64 + dt * 16 + fr) * PVA + (2 * kp + 1) * 32 + fq * 8);
                    const bf16x8 vf = __builtin_shufflevector(v0, v1, 0, 1, 2, 3, 4, 5, 6, 7);
                    oacc[g][dt] = __builtin_amdgcn_mfma_f32_16x16x32_bf16(vf, pb[kp], oacc[g][dt], 0, 0, 0); }
                oacc[g][dt] = oacc[g][dt] * inv; }
        }
        float ss = 0.f;
#pragma unroll
        for (int g = 0; g < 2; ++g)
#pragma unroll
            for (int dt = 0; dt < 4; ++dt) ss += (oacc[g][dt][0] * oacc[g][dt][0] + oacc[g][dt][1] * oacc[g][dt][1]) + (oacc[g][dt][2] * oacc[g][dt][2] + oacc[g][dt][3] * oacc[g][dt][3]);
        ss += __shfl_xor(ss, 16); ss += __shfl_xor(ss, 32); ss += __shfl_xor(ss, 1); ss += __shfl_xor(ss, 2);
        const float rs = rsqrtf(ss * (1.0f / 512.0f) + EPS);
#pragma unroll
        for (int g = 0; g < 2; ++g)
#pragma unroll
            for (int dt = 0; dt < 4; ++dt) { const int col = (g * 4 + hr) * 64 + dt * 16 + fq * 4; const f32x4 gn = *(const f32x4*)(an + col);
                const f32x4 y = oacc[g][dt] * rs * gn;
                *(u32x2*)(MIX + row * DM + 512 + col) = pack4(y); }
    }
}

__device__ __forceinline__ void p2_phase(const Params& P, LAS unsigned char* lds, int rep, bool do_hgrn, bool do_attn) {
    unsigned char* ws = P.ws; const int G = gridDim.x, bid = blockIdx.x;
    if (do_hgrn) {
        {
            const bf16_t* AK = (const bf16_t*)(ws + WS_AK); const bf16_t* AV = (const bf16_t*)(ws + WS_AV);
            constexpr int NPW = NBATCH * 128 * 16, NSN = DBATCH * DSEQ * 16, NPM = NBATCH * NMETA * 16;
            for (int i = bid * 512 + threadIdx.x; i < NPW + NSN + NPM; i += G * 512) {
                int src_row; size_t dk, dv; const int pc = i & 15;
                if (i < NPW) { const int r = i >> 4, b = r >> 7, s = r & 127; src_row = b * SEQ + (SEQ - 128) + s; dk = OFF_PWK + (size_t)r * 128; dv = OFF_PWV + (size_t)r * 128; }
                else if (i < NPW + NSN) { const int r = (i - NPW) >> 4; src_row = ROW_S + r; dk = OFF_SNK + (size_t)r * 128; dv = OFF_SNV + (size_t)r * 128; }
                else { const int r = (i - NPW - NSN) >> 4, m = r & 15; src_row = ROW_M + m; dk = OFF_PMK + (size_t)r * 128; dv = OFF_PMV + (size_t)r * 128; }
                const u32x4 kq = *(const u32x4*)(AK + (size_t)src_row * 128 + pc * 8), vq = *(const u32x4*)(AV + (size_t)src_row * 128 + pc * 8);
                float* ko = P.out + dk + pc * 8; float* vo = P.out + dv + pc * 8;
                *(f32x4*)ko = (f32x4){bflo(kq.x), bfhi(kq.x), bflo(kq.y), bfhi(kq.y)}; *(f32x4*)(ko + 4) = (f32x4){bflo(kq.z), bfhi(kq.z), bflo(kq.w), bfhi(kq.w)};
                *(f32x4*)vo = (f32x4){bflo(vq.x), bfhi(vq.x), bflo(vq.y), bfhi(vq.y)}; *(f32x4*)(vo + 4) = (f32x4){bflo(vq.z), bfhi(vq.z), bflo(vq.w), bfhi(vq.w)};
            }
        }
    }
    {
        if (do_hgrn) for (int u = bid; u < 160; u += G) hgrn_unit(P, lds, u < 128 ? 0 : 1, u < 128 ? (u >> 2) : ((u - 128) >> 2), u & 3);
        unsigned* ctr = (unsigned*)(ws + WS_CTL) + rep;
        LAS unsigned* slot = (LAS unsigned*)(lds + LDS_BYTES - 64);
        if (do_attn) for (;;) {
            __syncthreads();
            if (threadIdx.x == 0) *slot = atomicAdd(ctr, 1u);
            __syncthreads();
            const unsigned u = *slot;
            if (u >= 8u + 1024u) break;
            if (u < 8u) attn_unit(P, lds, 1, (int)u, 0); else attn_unit(P, lds, 0, (int)((u - 8u) >> 5), (int)((u - 8u) & 31u));
        }
    }
}

#define XB_TMO      128
#define XB_XCNT(j)  (256  + 64 * (j))
#define XB_XSUB(j)  (1280 + 64 * (j))
#define XB_XGEN(j)  (2304 + 64 * (j))
#define XB_TOP      3328
#define XB_TOPGEN   3392
#define XCD_BAR_WORDS 3456
#define XB_SPIN_CAP (1u << 18)
static_assert(XCD_BAR_WORDS * 4 <= WS_BAR_BYTES, "barrier words");
__device__ __forceinline__ unsigned xb_ld(unsigned* p)              { return __hip_atomic_load(p, __ATOMIC_RELAXED, __HIP_MEMORY_SCOPE_AGENT); }
__device__ __forceinline__ unsigned xb_add(unsigned* p, unsigned v) { return __hip_atomic_fetch_add(p, v, __ATOMIC_RELAXED, __HIP_MEMORY_SCOPE_AGENT); }
__device__ __forceinline__ unsigned xb_xcc_id() { return (unsigned)__builtin_amdgcn_s_getreg((3 << 11) | 20) & 0xFu; }
#define XB_SPIN(cond, bar) do { unsigned _sp = 0; while (cond) { __builtin_amdgcn_s_sleep(1); \
    if ((++_sp & 255u) == 0u) { if (xb_ld(&(bar)[XB_TMO])) break; if (_sp > XB_SPIN_CAP) { atomicAdd(&(bar)[XB_TMO], 1u); break; } } } } while (0)
struct XcdBarrier { unsigned* bar; unsigned x; volatile LAS unsigned* st; };
__device__ __forceinline__ XcdBarrier xcd_barrier_post(unsigned* bar, volatile LAS unsigned* st) {
    XcdBarrier b; b.bar = bar; b.x = xb_xcc_id(); b.st = st;
    if (threadIdx.x == 0) (void)xb_add(&bar[XB_XCNT(b.x)], 1u);
    return b;
}
__device__ __forceinline__ void xcd_barrier_complete(unsigned* bar, unsigned x, unsigned& nloc, unsigned& nx) {
    const unsigned G = gridDim.x * gridDim.y * gridDim.z;
    unsigned sum, cnt, mine, sp = 0u;
    for (;;) {
        sum = 0u; cnt = 0u; mine = 0u;
#pragma unroll
        for (unsigned j = 0; j < 16; ++j) { const unsigned c = xb_ld(&bar[XB_XCNT(j)]); sum += c; cnt += (c > 0u) ? 1u : 0u; mine = (j == x) ? c : mine; }
        if (sum == G) break;
        __builtin_amdgcn_s_sleep(1);
        if ((++sp & 255u) == 0u) { if (xb_ld(&bar[XB_TMO])) break; if (sp > XB_SPIN_CAP) { atomicAdd(&bar[XB_TMO], 1u); break; } }
    }
    nloc = mine > 0u ? mine : 1u; nx = cnt > 0u ? cnt : 1u;
}
__device__ __forceinline__ void xcd_barrier(const XcdBarrier& b) {
    asm volatile("s_waitcnt vmcnt(0)" ::: "memory");
    __syncthreads();
    if (threadIdx.x == 0) {
        unsigned* bar = b.bar;
        __builtin_amdgcn_s_waitcnt(0);
        unsigned nloc = b.st[0], nx = b.st[1];
        if (nloc == 0u) { xcd_barrier_complete(bar, b.x, nloc, nx); b.st[0] = nloc; b.st[1] = nx; }
        const unsigned old = xb_add(&bar[XB_XSUB(b.x)], 1u);
        const unsigned gen = old / nloc;
        if (old + 1u == (gen + 1u) * nloc) {
            __builtin_amdgcn_fence(__ATOMIC_RELEASE, "agent");
            asm volatile("s_waitcnt vmcnt(0)" ::: "memory");
            const unsigned og = xb_add(&bar[XB_TOP], 1u);
            const unsigned tg = og / nx;
            if (og + 1u == (tg + 1u) * nx) xb_add(&bar[XB_TOPGEN], 1u);
            else XB_SPIN(xb_ld(&bar[XB_TOPGEN]) == tg, bar);
            __builtin_amdgcn_fence(__ATOMIC_ACQUIRE, "agent");
            xb_add(&bar[XB_XGEN(b.x)], 1u);
            asm volatile("s_waitcnt vmcnt(0)" ::: "memory");
        } else {
            XB_SPIN(xb_ld(&bar[XB_XGEN(b.x)]) == gen, bar);
            __builtin_amdgcn_fence(__ATOMIC_ACQUIRE, "agent");
            asm volatile("s_waitcnt vmcnt(0)" ::: "memory");
        }
    }
    __syncthreads();
}

__global__ void __launch_bounds__(512, 2) hymba_fwd(Params P) {
    extern __shared__ __attribute__((aligned(16))) unsigned char smem[];
    LAS unsigned char* lds = (LAS unsigned char*)smem;
    cg::grid_group grid = cg::this_grid();
    unsigned char* ws = P.ws;
    const int G = gridDim.x, bid = blockIdx.x;
    volatile LAS unsigned* xst = (volatile LAS unsigned*)(lds + LDS_BYTES - 32);
    if (threadIdx.x == 0) { xst[0] = 0u; xst[1] = 0u; }
    __syncthreads();
    const XcdBarrier xbar = xcd_barrier_post((unsigned*)(ws + WS_BAR), xst);

    p0_prologue(P, lds);
    xcd_barrier(xbar);

    {
        pg8::Gemm g{(const bf16_t*)(ws + WS_XN), (const bf16_t*)(ws + WS_WIN), RTOT, NIN, DM}; pg8::StaticOrder S; S.init(RTOT, NIN, DM, G, bid);
        EpiIn E{ws, P.out};
#pragma unroll 1
        for (int rep = 0; rep < REP_P1; ++rep) { pg8::gemm_phase<EpiIn, pg8::StaticOrder>(lds, g, S, E); if (rep + 1 < REP_P1) grid.sync(); }
    }
    xcd_barrier(xbar);

    p2_phase(P, lds, 0, true, true);
#if REP_P2 > 1
    grid.sync();
    p2_phase(P, lds, 1, false, true);
#endif
    xcd_barrier(xbar);

    {
        pg8::Gemm g{(const bf16_t*)(ws + WS_MIX), (const bf16_t*)(ws + WS_WOUT), MROWS, DM, DM}; pg8::StaticOrder S; S.init(MROWS, DM, DM, G, bid);
        EpiOut E{(bf16_t*)(ws + WS_XN), (float*)(ws + WS_SS1), (const float*)(ws + WS_SS2), (const float*)(ws + WS_GINV)};
        pg8::gemm_phase<EpiOut, pg8::StaticOrder>(lds, g, S, E);
    }
    xcd_barrier(xbar);

    {
        {
            const bf16_t* HBs = (const bf16_t*)(ws + WS_XN) + (size_t)ROW_S * DM; float* Ys = P.out + OFF_Y + (size_t)ROW_S * DM;
            int t2 = threadIdx.x; asm volatile("" : "+v"(t2));
            for (int i = bid * 512 + t2; i < DBATCH * DSEQ * DM / 8; i += G * 512) { const u32x4 hb = *(const u32x4*)(HBs + (size_t)i * 8);
                *(f32x4*)(Ys + (size_t)i * 8) = (f32x4){bflo(hb.x), bfhi(hb.x), bflo(hb.y), bfhi(hb.y)}; *(f32x4*)(Ys + (size_t)i * 8 + 4) = (f32x4){bflo(hb.z), bfhi(hb.z), bflo(hb.w), bfhi(hb.w)}; }
        }
        pg8::Gemm g{(const bf16_t*)(ws + WS_XN), (const bf16_t*)(ws + WS_WFI), MROWS, NFF2, DM}; pg8::StaticOrder S; S.init(MROWS, NFF2, DM, G, bid);
        EpiSwi E{(bf16_t*)(ws + WS_ACT), (float*)(ws + WS_SS1)};
#pragma unroll 1
        for (int rep = 0; rep < REP_P4; ++rep) { pg8::gemm_phase<EpiSwi, pg8::StaticOrder>(lds, g, S, E); if (rep + 1 < REP_P4) grid.sync(); }
    }
    xcd_barrier(xbar);

    {
        pg8::Gemm g{(const bf16_t*)(ws + WS_ACT), (const bf16_t*)(ws + WS_WFO), MROWS, DM, DFF}; pg8::DownOrder S; S.init(G, bid);
        const int fused = (G == 256) ? 1 : 0;
        EpiDown E{P.out + OFF_Y, (const bf16_t*)(ws + WS_XN), (unsigned*)(ws + WS_CTL) + 16, P.in[18], (float*)(ws + WS_MIX), (LAS float*)(lds + 131072), fused};
        pg8::gemm_phase<EpiDown, pg8::DownOrder>(lds, g, S, E);
        {
            xcd_barrier(xbar);
            int t2 = threadIdx.x; asm volatile("" : "+v"(t2));
            const int lane = t2 & 63, gw = bid * 8 + (t2 >> 6), NGW = G * 8;
            f32x4 gv[4];
#pragma unroll
            for (int j = 0; j < 4; ++j) gv[j] = *(const f32x4*)(P.in[18] + 4 * lane + 256 * j);
            for (int r4 = ROW_S / 4 + gw; r4 < MROWS / 4; r4 += NGW) norm_rows<4>(P.out + OFF_Y + (size_t)r4 * 4 * DM, gv, lane);
            if (!fused) {
                const bf16_t* H2 = (const bf16_t*)(ws + WS_XN); float* Yp = P.out + OFF_Y;
                f32x4 fg[2][2];
#pragma unroll
                for (int hh = 0; hh < 2; ++hh) { fg[hh][0] = *(const f32x4*)(P.in[18] + hh * 512 + 8 * lane); fg[hh][1] = *(const f32x4*)(P.in[18] + hh * 512 + 8 * lane + 4); }
                for (int r4 = gw; r4 < ROW_S / 4; r4 += NGW) {
                    u32x4 hb[4][2];
#pragma unroll
                    for (int rr = 0; rr < 4; ++rr)
#pragma unroll
                        for (int hh = 0; hh < 2; ++hh) hb[rr][hh] = *(const u32x4*)(H2 + (size_t)(r4 * 4 + rr) * DM + hh * 512 + 8 * lane);
#pragma unroll
                    for (int rr = 0; rr < 4; ++rr) { f32x4 v[2][2]; float q = 0.f;
#pragma unroll
                        for (int hh = 0; hh < 2; ++hh) { v[hh][0] = (f32x4){bflo(hb[rr][hh].x), bfhi(hb[rr][hh].x), bflo(hb[rr][hh].y), bfhi(hb[rr][hh].y)}; v[hh][1] = (f32x4){bflo(hb[rr][hh].z), bfhi(hb[rr][hh].z), bflo(hb[rr][hh].w), bfhi(hb[rr][hh].w)};
                            q += (v[hh][0][0] * v[hh][0][0] + v[hh][0][1] * v[hh][0][1]) + (v[hh][0][2] * v[hh][0][2] + v[hh][0][3] * v[hh][0][3]) + (v[hh][1][0] * v[hh][1][0] + v[hh][1][1] * v[hh][1][1]) + (v[hh][1][2] * v[hh][1][2] + v[hh][1][3] * v[hh][1][3]); }
                        const float rs = rsqrtf(wave_sum(q) * (1.0f / DM) + EPS);
                        float* yr = Yp + (size_t)(r4 * 4 + rr) * DM + 8 * lane;
#pragma unroll
                        for (int hh = 0; hh < 2; ++hh) { *(f32x4*)(yr + hh * 512) = v[hh][0] * rs * fg[hh][0]; *(f32x4*)(yr + hh * 512 + 4) = v[hh][1] * rs * fg[hh][1]; } }
                }
            }
        }
    }

}

extern "C" void kernel_launch(void* const* d_in, const int* in_sizes, int n_in, void* d_out, int out_size, void* d_ws, size_t ws_size, hipStream_t stream) {
    static int grid = 0;
    if (grid == 0) {
        int dev = 0, cus = 0, per_cu = 0;
        hipGetDevice(&dev);
        hipDeviceGetAttribute(&cus, hipDeviceAttributeMultiprocessorCount, dev);
        hipFuncSetAttribute((const void*)hymba_fwd, hipFuncAttributeMaxDynamicSharedMemorySize, LDS_BYTES);
        hipOccupancyMaxActiveBlocksPerMultiprocessor(&per_cu, (const void*)hymba_fwd, 512, LDS_BYTES);
        if (per_cu < 1) { fprintf(stderr, "occupancy query reports %d blocks per CU\n", per_cu); per_cu = 1; }
        (void)hipGetLastError();
        grid = cus;
        if (ws_size < WS_END) fprintf(stderr, "workspace too small: %zu < %zu\n", ws_size, (size_t)WS_END);
    }
    Params p{};
    for (int i = 0; i < 19; ++i) p.in[i] = (const float*)d_in[i];
    p.out = (float*)d_out; p.ws = (unsigned char*)d_ws;
    if (hipMemsetAsync((unsigned char*)d_ws + WS_BAR, 0, WS_BAR_BYTES, stream) != hipSuccess) fprintf(stderr, "hipMemsetAsync of the barrier words failed\n");
    void* args[] = {&p};
    hipError_t e = hipLaunchCooperativeKernel((const void*)hymba_fwd, dim3(grid), dim3(512), args, LDS_BYTES, stream);
    if (e != hipSuccess) fprintf(stderr, "cooperative launch failed: %s (grid %d)\n", hipGetErrorString(e), grid);
}
```

```cpp
#include <hip/hip_runtime.h>
#include <hip/hip_cooperative_groups.h>
#include <cstdio>
#include <cstdint>
namespace cg = cooperative_groups;

#define LAS __attribute__((address_space(3)))
typedef unsigned short bf16_t;
typedef short bf16x8 __attribute__((ext_vector_type(8)));
typedef short s16x4 __attribute__((ext_vector_type(4)));
typedef float f32x4 __attribute__((ext_vector_type(4)));
typedef float f32x2 __attribute__((ext_vector_type(2)));
typedef unsigned u32x4 __attribute__((ext_vector_type(4)));
typedef unsigned u32x2 __attribute__((ext_vector_type(2)));

constexpr int DM = 1024, NBATCH = 32, SEQ = 2048, DBATCH = 8, DSEQ = 32, NMETA = 16, PAST = 1024;
constexpr int ROW_S = NBATCH * SEQ;
constexpr int ROW_M = ROW_S + DBATCH * DSEQ;
constexpr int ROW_END = ROW_M + NMETA;
constexpr int RTOT = 258 * 256;
constexpr int MROWS = 257 * 256;
constexpr int NIN = 2816, DFF = 2816, NFF2 = 5632;
constexpr int NPOS = 2064;
constexpr float EPS = 1e-6f;
constexpr float LOG2E = 1.4426950408889634f, QSCALE = 0.125f * LOG2E;
constexpr size_t OFF_Y = 0, OFF_PMK = 67371008, OFF_PMV = 67436544, OFF_PWK = 67502080, OFF_PWV = 68026368, OFF_PST = 68550656,
                 OFF_SNK = 70647808, OFF_SNV = 70680576, OFF_SST = 70713344;
constexpr size_t al256(size_t x) { return (x + 255) & ~(size_t)255; }
constexpr size_t WS_CTL = 0;
constexpr size_t WS_LB = 4096;
constexpr size_t WS_ROPE = WS_LB + 2048;
constexpr size_t WS_SS1 = al256(WS_ROPE + (size_t)NPOS * 32 * 8);
constexpr size_t WS_SS2 = al256(WS_SS1 + (size_t)RTOT * 4);
constexpr size_t WS_GINV = al256(WS_SS2 + (size_t)RTOT * 4);
constexpr size_t WS_BAR = al256(WS_GINV + (size_t)DM * 4);
constexpr size_t WS_BAR_BYTES = 16384;
constexpr size_t WS_WIN = al256(WS_BAR + WS_BAR_BYTES);
constexpr size_t WS_WOUT = WS_WIN + (size_t)NIN * DM * 2;
constexpr size_t WS_WFI = WS_WOUT + (size_t)DM * DM * 2;
constexpr size_t WS_WFO = WS_WFI + (size_t)NFF2 * DM * 2;
constexpr size_t WS_XN = WS_WFO + (size_t)DM * DFF * 2;
constexpr size_t WS_BIG = WS_XN + (size_t)RTOT * DM * 2;
constexpr size_t WS_QH = WS_BIG;
constexpr size_t WS_LF = WS_QH + (size_t)RTOT * 512 * 2;
constexpr size_t WS_VH = WS_LF + (size_t)RTOT * 512 * 4;
constexpr size_t WS_GH = WS_VH + (size_t)RTOT * 512 * 2;
constexpr size_t WS_AQ = WS_GH + (size_t)RTOT * 512 * 2;
constexpr size_t WS_BIG_END = WS_AQ + (size_t)RTOT * 512 * 2;
constexpr size_t WS_ACT = WS_BIG;
static_assert(WS_ACT + (size_t)RTOT * DFF * 2 <= WS_BIG_END, "ACT overlay");
constexpr size_t WS_AK = WS_BIG_END;
constexpr size_t WS_AV = WS_AK + (size_t)RTOT * 128 * 2;
constexpr size_t WS_MIX = WS_AV + (size_t)RTOT * 128 * 2;
constexpr size_t WS_END = WS_MIX + (size_t)RTOT * DM * 2;
static_assert(WS_END <= (size_t)1 << 30, "workspace");

constexpr int LDS_BYTES = 147456;
#define REP_P1 1
#define REP_P2 1
#define REP_P4 1

struct Params { const float* in[19]; float* out; unsigned char* ws; };

__device__ __forceinline__ unsigned cvt_pk_bf16(float lo, float hi) { unsigned r; asm volatile("v_cvt_pk_bf16_f32 %0, %1, %2" : "=v"(r) : "v"(lo), "v"(hi)); return r; }
typedef _Float16 f16x2 __attribute__((ext_vector_type(2)));
__device__ __forceinline__ unsigned pk_f16(float a, float b) { f16x2 h; h.x = (_Float16)a; h.y = (_Float16)b; return __builtin_bit_cast(unsigned, h); }
__device__ __forceinline__ float bf2f(unsigned short b) { return __builtin_bit_cast(float, (unsigned)b << 16); }
__device__ __forceinline__ float bflo(unsigned u) { return __builtin_bit_cast(float, u << 16); }
__device__ __forceinline__ float bfhi(unsigned u) { return __builtin_bit_cast(float, u & 0xffff0000u); }
__device__ __forceinline__ float sigmoidf_(float v) { return __builtin_amdgcn_rcpf(1.0f + __expf(-v)); }
__device__ __forceinline__ float siluf_(float v) { return v * sigmoidf_(v); }
__device__ __forceinline__ float wave_sum(float v) {
#pragma unroll
    for (int o = 1; o < 64; o <<= 1) v += __shfl_xor(v, o);
    return v;
}
#define LDS_WAIT() asm volatile("s_waitcnt lgkmcnt(0)" ::: "memory")

namespace pg8 {
constexpr int BM = 256, BK = 64, HALF = 128, HTB = HALF * BK * 2, NXCD = 8, WGM = 8;
__host__ __device__ __forceinline__ int lds_byte(int r, int c) { const int st = (r >> 4) * 2 + (c >> 5), rr = r & 15, cc = c & 31, ob = rr * 64 + cc * 2; return st * 1024 + (ob ^ (((ob >> 9) & 1) << 5)); }
__host__ __device__ __forceinline__ void stage_rc(int b, int& R, int& C) { const int st = b / 1024, sb = b % 1024, swz = sb ^ (((sb >> 9) & 1) << 5); R = (st >> 1) * 16 + swz / 64; C = (st & 1) * 32 + (swz % 64) / 2; }
__host__ __device__ __forceinline__ int perm32(int rho) { const int n = rho >> 4, i = rho & 15; return 8 * (i >> 2) + 4 * n + (i & 3); }

struct Unit { int pm, pn, ko, nt; };
struct Gemm { const bf16_t* A; const bf16_t* Bt; int M, N, K; };

struct StaticOrder {
    int nM, nN, nwg, G, c, ntk;
    __device__ void init(int M, int N, int K, int G_, int c_) { nM = M / BM; nN = N / BM; nwg = nM * nN; G = G_; c = c_; ntk = K / BK; }
    __device__ bool next(int i, Unit& u) const {
        const long L = (long)i * G + c; if (L >= nwg) return false;
        int wgid = (int)L; { const int q = nwg / NXCD, r = nwg % NXCD, xcd = wgid % NXCD, off = wgid / NXCD; wgid = (xcd < r ? xcd * (q + 1) : r * (q + 1) + (xcd - r) * q) + off; }
        const int nig = WGM * nN, gid = wgid / nig, fm = gid * WGM, gsz = (nM - fm) < WGM ? (nM - fm) : WGM;
        u.pm = fm + ((wgid % nig) % gsz); u.pn = (wgid % nig) / gsz; u.ko = 0; u.nt = ntk; return true;
    }
};
struct DownOrder {
    StaticOrder P; int G, c;
    __device__ void init(int G_, int c_) { P.init(256 * 256, DM, DFF, G_, c_); G = G_; c = c_; }
    __device__ bool next(int i, Unit& u) const {
        const long L = (long)i * G + c; if (L < P.nwg) return P.next(i, u);
        const int x = (int)(L - P.nwg); if (x >= 44) return false;
        u.pm = 256; u.pn = x & 3; u.ko = (x >> 2) * 256; u.nt = 4; return true;
    }
};

template <class Epi, class Sched>
__device__ __forceinline__ void gemm_phase(LAS unsigned char* lds, const Gemm g, const Sched& S, const Epi& E) {
    int tid = threadIdx.x; asm volatile("" : "+v"(tid));
    const int wid = __builtin_amdgcn_readfirstlane(tid >> 6), lane = tid & 63, wr = wid >> 2, wc = wid & 3, fr = lane & 15, fq = lane >> 4;
    const int K = g.K;
    unsigned voffA[2], voffB[2];
#pragma unroll
    for (int i = 0; i < 2; ++i) { int R, C; stage_rc(tid * 16 + i * 8192, R, C); const int Rb = (R & ~31) + perm32(R & 31);
        voffA[i] = (unsigned)(R * K + C) * 2u; voffB[i] = (unsigned)(Rb * K + C) * 2u; }
    const size_t kstep = (size_t)(BK * 2);
    const size_t hstep = (size_t)HALF * K * 2;
    const size_t tstep = 2 * hstep;
    const unsigned ldsw = (unsigned)wid * 1024u;
    const int aoff = lds_byte(wr * 64 + fr, fq * 8), boff = lds_byte(wc * 32 + fr, fq * 8);
#define PG8_SA(b, h) (((b) * 2 + (h)) * HTB)
#define PG8_SB(b, h) ((4 + (b) * 2 + (h)) * HTB)
#define PG8_STAGE(bufoff, gbase, voff) do { _Pragma("unroll") for (int _i = 0; _i < 2; ++_i) \
        __builtin_amdgcn_global_load_lds((const unsigned*)((const char*)(gbase) + (voff)[_i]), (LAS unsigned*)(lds + (bufoff) + ldsw + _i * 8192), 16, 0, 0); } while (0)
#define PG8_LDA(dst, b, h) do { _Pragma("unroll") for (int m = 0; m < 4; ++m) _Pragma("unroll") for (int k = 0; k < 2; ++k) dst[m][k] = *(const LAS bf16x8*)(lds + PG8_SA(b, h) + aoff + m * 2048 + k * 1024); } while (0)
#define PG8_LDB(dst, b, h) do { _Pragma("unroll") for (int n = 0; n < 2; ++n) _Pragma("unroll") for (int k = 0; k < 2; ++k) dst[n][k] = *(const LAS bf16x8*)(lds + PG8_SB(b, h) + boff + n * 2048 + k * 1024); } while (0)
#define PG8_MMA(ai, bj, At, Bt) do { __builtin_amdgcn_s_setprio(1); _Pragma("unroll") for (int m = 0; m < 4; ++m) _Pragma("unroll") for (int n = 0; n < 2; ++n) _Pragma("unroll") for (int k = 0; k < 2; ++k) \
        acc[ai][bj][m][n] = __builtin_amdgcn_mfma_f32_16x16x32_bf16(Bt[n][k], At[m][k], acc[ai][bj][m][n], 0, 0, 0); __builtin_amdgcn_s_setprio(0); } while (0)
#define PG8_WAIT_V(n) asm volatile("s_waitcnt vmcnt(" #n ")" ::: "memory")
#define PG8_WAIT_L(n) asm volatile("s_waitcnt lgkmcnt(" #n ")" ::: "memory")
#define PG8_BAR __builtin_amdgcn_s_barrier()
#define PG8_SCHED __builtin_amdgcn_sched_barrier(0)
    Unit cur, nxt; int ui = 0;
    if (!S.next(0, cur)) return;
    f32x4 acc[2][2][4][2];
#pragma unroll
    for (int a = 0; a < 2; ++a)
#pragma unroll
        for (int b = 0; b < 2; ++b)
#pragma unroll
            for (int m = 0; m < 4; ++m)
#pragma unroll
                for (int n = 0; n < 2; ++n) acc[a][b][m][n] = (f32x4){0.f, 0.f, 0.f, 0.f};
    bf16x8 At[4][2], B0[2][2], B1[2][2];
    const char* cA = (const char*)g.A + (size_t)cur.pm * tstep + (size_t)cur.ko * 2; const char* cB = (const char*)g.Bt + (size_t)cur.pn * tstep + (size_t)cur.ko * 2;
    PG8_STAGE(PG8_SB(0, 0), cB, voffB); PG8_STAGE(PG8_SB(0, 1), cB + hstep, voffB); PG8_STAGE(PG8_SA(0, 0), cA, voffA); PG8_STAGE(PG8_SA(0, 1), cA + hstep, voffA);
    if (wr == 1) PG8_BAR;
    PG8_WAIT_V(2); PG8_BAR;
    PG8_STAGE(PG8_SB(1, 0), cB + kstep, voffB); PG8_STAGE(PG8_SA(1, 0), cA + kstep, voffA); PG8_STAGE(PG8_SB(1, 1), cB + hstep + kstep, voffB);
    PG8_WAIT_V(6); PG8_BAR;
    for (;;) {
        const bool has_next = S.next(ui + 1, nxt);
        const char* nA = has_next ? (const char*)g.A + (size_t)nxt.pm * tstep + (size_t)nxt.ko * 2 : cA; const char* nB = has_next ? (const char*)g.Bt + (size_t)nxt.pn * tstep + (size_t)nxt.ko * 2 : cB;
        const int nt = cur.nt;
        for (int t = 0; t < nt; t += 2) {
            const bool last = (t == nt - 2);
            const char* a1 = cA + (size_t)(t + 1) * kstep;
            const char* a2 = last ? nA : cA + (size_t)(t + 2) * kstep; const char* b2 = last ? nB : cB + (size_t)(t + 2) * kstep;
            const char* a3 = a2 + kstep; const char* b3 = b2 + kstep;
            PG8_LDB(B0, 0, 0); PG8_LDB(B1, 0, 1); PG8_SCHED; PG8_LDA(At, 0, 0); PG8_STAGE(PG8_SA(1, 1), a1 + hstep, voffA);
            PG8_WAIT_V(8); PG8_WAIT_L(0); PG8_BAR; PG8_MMA(0, 0, At, B0); PG8_MMA(0, 1, At, B1); PG8_BAR; PG8_SCHED;
            PG8_LDA(At, 0, 1); PG8_STAGE(PG8_SB(0, 0), b2, voffB); PG8_STAGE(PG8_SB(0, 1), b2 + hstep, voffB); PG8_STAGE(PG8_SA(0, 0), a2, voffA);
            PG8_WAIT_V(8); PG8_WAIT_L(0); PG8_BAR; PG8_MMA(1, 0, At, B0); PG8_MMA(1, 1, At, B1); PG8_BAR; PG8_SCHED;
            PG8_LDB(B0, 1, 0); PG8_LDB(B1, 1, 1); PG8_SCHED; PG8_LDA(At, 1, 0); PG8_STAGE(PG8_SA(0, 1), a2 + hstep, voffA);
            PG8_WAIT_V(8); PG8_WAIT_L(0); PG8_BAR; PG8_MMA(0, 0, At, B0); PG8_MMA(0, 1, At, B1); PG8_BAR; PG8_SCHED;
            PG8_LDA(At, 1, 1); PG8_STAGE(PG8_SB(1, 0), b3, voffB); PG8_STAGE(PG8_SB(1, 1), b3 + hstep, voffB); PG8_STAGE(PG8_SA(1, 0), a3, voffA);
            PG8_WAIT_V(8); PG8_WAIT_L(0); PG8_BAR; PG8_MMA(1, 0, At, B0); PG8_MMA(1, 1, At, B1); PG8_BAR; PG8_SCHED;
        }
        if (wr == 0) PG8_BAR;
        E(acc, cur, wr, wc, fr, fq);
        if (!has_next) break;
#pragma unroll
        for (int a = 0; a < 2; ++a)
#pragma unroll
            for (int b = 0; b < 2; ++b)
#pragma unroll
                for (int m = 0; m < 4; ++m)
#pragma unroll
                    for (int n = 0; n < 2; ++n) acc[a][b][m][n] = (f32x4){0.f, 0.f, 0.f, 0.f};
        cur = nxt; cA = nA; cB = nB; ++ui;
        if (wr == 1) PG8_BAR;
    }
    PG8_WAIT_V(0);
    PG8_BAR;
#undef PG8_SA
#undef PG8_SB
#undef PG8_STAGE
#undef PG8_LDA
#undef PG8_LDB
#undef PG8_MMA
#undef PG8_WAIT_V
#undef PG8_WAIT_L
#undef PG8_BAR
#undef PG8_SCHED
}
}

__device__ __forceinline__ u32x4 pack8(const f32x4& a, const f32x4& b) {
    u32x4 w; w.x = cvt_pk_bf16(a[0], a[1]); w.y = cvt_pk_bf16(a[2], a[3]); w.z = cvt_pk_bf16(b[0], b[1]); w.w = cvt_pk_bf16(b[2], b[3]); return w;
}
__device__ __forceinline__ u32x2 pack4(const f32x4& a) { u32x2 w; w.x = cvt_pk_bf16(a[0], a[1]); w.y = cvt_pk_bf16(a[2], a[3]); return w; }

__device__ __forceinline__ int row_pos(int row) {
    int pos;
    if (row < ROW_S) pos = NMETA + (row & (SEQ - 1));
    else if (row < ROW_M) pos = NMETA + PAST + ((row - ROW_S) & (DSEQ - 1));
    else pos = row - ROW_M;
    return pos < NPOS ? pos : NPOS - 1;
}
__device__ __forceinline__ void kv_out(float* out, size_t off_pw, size_t off_sn, size_t off_pm, int row, int c, const f32x4& v) {
    if (row < ROW_S) { const int s = row & (SEQ - 1); if (s >= SEQ - 128) { const int b = row >> 11; *(f32x4*)(out + off_pw + ((size_t)(b * 128 + s - (SEQ - 128))) * 128 + c) = v; } }
    else if (row < ROW_M) { *(f32x4*)(out + off_sn + (size_t)(row - ROW_S) * 128 + c) = v; }
    else if (row < ROW_END) { const int m = row - ROW_M;
        for (int b = 0; b < NBATCH; ++b) *(f32x4*)(out + off_pm + (size_t)(b * NMETA + m) * 128 + c) = v; }
}

struct EpiIn {
    unsigned char* ws; float* out;
    __device__ __forceinline__ void rope4(const f32x4& x1, const f32x4& x2, const f32x4& cs0, const f32x4& cs1, f32x4& o1, f32x4& o2) const {
        o1[0] = x1[0] * cs0[0] - x2[0] * cs0[1]; o2[0] = x2[0] * cs0[0] + x1[0] * cs0[1];
        o1[1] = x1[1] * cs0[2] - x2[1] * cs0[3]; o2[1] = x2[1] * cs0[2] + x1[1] * cs0[3];
        o1[2] = x1[2] * cs1[0] - x2[2] * cs1[1]; o2[2] = x2[2] * cs1[0] + x1[2] * cs1[1];
        o1[3] = x1[3] * cs1[2] - x2[3] * cs1[3]; o2[3] = x2[3] * cs1[2] + x1[3] * cs1[3];
    }
    __device__ __forceinline__ void operator()(const f32x4 (&acc)[2][2][4][2], const pg8::Unit& u, int wr, int wc, int fr, int fq) const {
        const int pn = u.pn, row0 = u.pm * 256 + wr * 64 + fr;
        if (pn < 2 || (pn >= 4 && pn < 8)) {
            bf16_t* dst = (bf16_t*)(ws + (pn < 2 ? WS_QH : (pn < 6 ? WS_VH : WS_GH))); const bool act = (pn < 2) || (pn >= 6);
            const int c0 = (pn & 1) * 256 + wc * 32 + fq * 8;
#pragma unroll
            for (int ai = 0; ai < 2; ++ai)
#pragma unroll
                for (int m = 0; m < 4; ++m) { const int row = row0 + ai * 128 + m * 16;
#pragma unroll
                    for (int bj = 0; bj < 2; ++bj) { f32x4 v0 = acc[ai][bj][m][0], v1 = acc[ai][bj][m][1];
                        if (act) {
#pragma unroll
                            for (int i = 0; i < 4; ++i) { v0[i] = siluf_(v0[i]); v1[i] = siluf_(v1[i]); } }
                        *(u32x4*)(dst + (size_t)row * 512 + c0 + bj * 128) = pack8(v0, v1); } }
        } else if (pn < 4) {
            const int c0 = (pn & 1) * 256 + wc * 32 + fq * 8;
            f32x4 lbv[2][2]; const float* lb = (const float*)(ws + WS_LB); bf16_t* LF = (bf16_t*)(ws + WS_LF);
#pragma unroll
            for (int bj = 0; bj < 2; ++bj) { lbv[bj][0] = *(const f32x4*)(lb + c0 + bj * 128); lbv[bj][1] = *(const f32x4*)(lb + c0 + bj * 128 + 4); }
#pragma unroll
            for (int ai = 0; ai < 2; ++ai)
#pragma unroll
                for (int m = 0; m < 4; ++m) { const int row = row0 + ai * 128 + m * 16;
#pragma unroll
                    for (int bj = 0; bj < 2; ++bj) { f32x4 o[2];
#pragma unroll
                        for (int n = 0; n < 2; ++n) { const f32x4 v = acc[ai][bj][m][n];
#pragma unroll
                            for (int i = 0; i < 4; ++i) { const float l = lbv[bj][n][i]; o[n][i] = __log2f(l + (1.0f - l) * sigmoidf_(v[i]));     } }
                        *(u32x4*)(LF + (size_t)row * 512 + c0 + bj * 128) = (u32x4){pk_f16(o[0][0], o[0][1]), pk_f16(o[0][2], o[0][3]), pk_f16(o[1][0], o[1][1]), pk_f16(o[1][2], o[1][3])}; } }
        } else if (pn < 10) {
            const int d_lo = (wc & 1) * 16 + fq * 4;
            const int d_w = (wc & 1) * 16 + ((fq & 1) ? 32 + (fq - 1) * 4 : fq * 4);
#pragma unroll
            for (int ai = 0; ai < 2; ++ai) {
                f32x4 cs[4][2];
#pragma unroll
                for (int m = 0; m < 4; ++m) { const float* rp = (const float*)(ws + WS_ROPE) + ((size_t)row_pos(row0 + ai * 128 + m * 16) * 32 + d_lo) * 2; cs[m][0] = *(const f32x4*)rp; cs[m][1] = *(const f32x4*)(rp + 4); }
#pragma unroll
                for (int m = 0; m < 4; ++m) { const int row = row0 + ai * 128 + m * 16;
#pragma unroll
                    for (int bj = 0; bj < 2; ++bj) { f32x4 o1, o2; rope4(acc[ai][bj][m][0], acc[ai][bj][m][1], cs[m][0], cs[m][1], o1, o2); o1 = o1 * QSCALE; o2 = o2 * QSCALE;
                        const u32x2 p1 = pack4(o1), p2 = pack4(o2);
                        const auto sx = __builtin_amdgcn_permlane16_swap(p1.x, p2.x, false, false), sy = __builtin_amdgcn_permlane16_swap(p1.y, p2.y, false, false);
                        bf16_t* p = (bf16_t*)(ws + WS_AQ) + (size_t)row * 512 + (pn - 8) * 256 + (bj * 2 + (wc >> 1)) * 64 + d_w;
                        *(u32x4*)p = (u32x4){sx[0], sy[0], sx[1], sy[1]}; } } }
        } else {
            const int d_lo = (wc & 1) * 16 + fq * 4, g = wc >> 1;
#pragma unroll
            for (int ai = 0; ai < 2; ++ai) {
                f32x4 cs[4][2];
#pragma unroll
                for (int m = 0; m < 4; ++m) { const float* rp = (const float*)(ws + WS_ROPE) + ((size_t)row_pos(row0 + ai * 128 + m * 16) * 32 + d_lo) * 2; cs[m][0] = *(const f32x4*)rp; cs[m][1] = *(const f32x4*)(rp + 4); }
#pragma unroll
                for (int m = 0; m < 4; ++m) { const int row = row0 + ai * 128 + m * 16;
                    f32x4 o1, o2; rope4(acc[ai][0][m][0], acc[ai][0][m][1], cs[m][0], cs[m][1], o1, o2);
                    bf16_t* p = (bf16_t*)(ws + WS_AK) + (size_t)row * 128 + g * 64 + d_lo;
                    *(u32x2*)p = pack4(o1); *(u32x2*)(p + 32) = pack4(o2);
                    const int c = wc * 32 + fq * 8;
                    *(u32x4*)((bf16_t*)(ws + WS_AV) + (size_t)row * 128 + c) = pack8(acc[ai][1][m][0], acc[ai][1][m][1]);
} }
        }
    }
};

struct EpiOut {
    bf16_t* HB; float* SS; const float* irs; const float* ginv;
    __device__ __forceinline__ void operator()(const f32x4 (&acc)[2][2][4][2], const pg8::Unit& u, int wr, int wc, int fr, int fq) const {
        const int row0 = u.pm * 256 + wr * 64 + fr, c0 = u.pn * 256 + wc * 32 + fq * 8;
        float irv[8];
#pragma unroll
        for (int i = 0; i < 8; ++i) irv[i] = irs[row0 + (i >> 2) * 128 + (i & 3) * 16];
        f32x4 gi[2][2];
#pragma unroll
        for (int bj = 0; bj < 2; ++bj) { gi[bj][0] = *(const f32x4*)(ginv + c0 + bj * 128); gi[bj][1] = *(const f32x4*)(ginv + c0 + bj * 128 + 4); }
#pragma unroll
        for (int ai = 0; ai < 2; ++ai) {
            u32x4 xbv[2][4][2];
#pragma unroll
            for (int m = 0; m < 4; ++m)
#pragma unroll
                for (int bj = 0; bj < 2; ++bj) xbv[ai][m][bj] = *(const u32x4*)(HB + (size_t)(row0 + ai * 128 + m * 16) * DM + c0 + bj * 128);
#pragma unroll
            for (int m = 0; m < 4; ++m) { const int row = row0 + ai * 128 + m * 16; const float ir = irv[ai * 4 + m]; float ss = 0.f;
#pragma unroll
                for (int bj = 0; bj < 2; ++bj) { bf16_t* hp = HB + (size_t)row * DM + c0 + bj * 128;
                    const u32x4 xb = xbv[ai][m][bj];
                    const f32x4 x0 = (f32x4){bflo(xb.x), bfhi(xb.x), bflo(xb.y), bfhi(xb.y)} * gi[bj][0] * ir, x1 = (f32x4){bflo(xb.z), bfhi(xb.z), bflo(xb.w), bfhi(xb.w)} * gi[bj][1] * ir;
                    const f32x4 h0 = acc[ai][bj][m][0] + x0, h1 = acc[ai][bj][m][1] + x1;
                    *(u32x4*)hp = pack8(h0, h1);
                    ss += (h0[0] * h0[0] + h0[1] * h0[1]) + (h0[2] * h0[2] + h0[3] * h0[3]) + (h1[0] * h1[0] + h1[1] * h1[1]) + (h1[2] * h1[2] + h1[3] * h1[3]); }
                ss += __shfl_xor(ss, 16); ss += __shfl_xor(ss, 32);
                if (fq == 0) atomicAdd(SS + row, ss); }
        }
    }
};

struct EpiSwi {
    bf16_t* ACT; float* SS;
    __device__ __forceinline__ void operator()(const f32x4 (&acc)[2][2][4][2], const pg8::Unit& u, int wr, int wc, int fr, int fq) const {
        const int row0 = u.pm * 256 + wr * 64 + fr;
        const int cw = u.pn * 128 + wc * 16 + ((fq & 1) ? 64 + (fq - 1) * 4 : fq * 4);
        float ssv[8];
#pragma unroll
        for (int i = 0; i < 8; ++i) ssv[i] = __hip_atomic_load(SS + row0 + (i >> 2) * 128 + (i & 3) * 16, __ATOMIC_RELAXED, __HIP_MEMORY_SCOPE_AGENT);
#pragma unroll
        for (int ai = 0; ai < 2; ++ai)
#pragma unroll
            for (int m = 0; m < 4; ++m) { const int row = row0 + ai * 128 + m * 16;
                const float rs = rsqrtf(ssv[ai * 4 + m] * (1.0f / DM) + EPS);
                u32x2 pk[2];
#pragma unroll
                for (int bj = 0; bj < 2; ++bj) { f32x4 a;
#pragma unroll
                    for (int i = 0; i < 4; ++i) { const float gt = acc[ai][bj][m][0][i] * rs, up = acc[ai][bj][m][1][i] * rs; a[i] = siluf_(gt) * up; }
                    pk[bj] = pack4(a); }
                const auto sx = __builtin_amdgcn_permlane16_swap(pk[0].x, pk[1].x, false, false), sy = __builtin_amdgcn_permlane16_swap(pk[0].y, pk[1].y, false, false);
                *(u32x4*)(ACT + (size_t)row * DFF + cw) = (u32x4){sx[0], sy[0], sx[1], sy[1]}; }
    }
};

__device__ __forceinline__ void st_wt8(float* p, float a, float b) {
    const unsigned long long v = (unsigned long long)__builtin_bit_cast(unsigned, a) | ((unsigned long long)__builtin_bit_cast(unsigned, b) << 32);
    __hip_atomic_store((unsigned long long*)p, v, __ATOMIC_RELAXED, __HIP_MEMORY_SCOPE_AGENT);
}
template <int NR>
__device__ __forceinline__ void norm_rows(float* y0, const f32x4 (&gv)[4], int lane) {
    f32x4 a[NR][4]; float sq[NR];
#pragma unroll
    for (int r = 0; r < NR; ++r)
#pragma unroll
        for (int j = 0; j < 4; ++j) a[r][j] = *(const f32x4*)(y0 + (size_t)r * DM + 4 * lane + 256 * j);
#pragma unroll
    for (int r = 0; r < NR; ++r) { float q = 0.f;
#pragma unroll
        for (int j = 0; j < 4; ++j) q += (a[r][j][0] * a[r][j][0] + a[r][j][1] * a[r][j][1]) + (a[r][j][2] * a[r][j][2] + a[r][j][3] * a[r][j][3]);
        sq[r] = rsqrtf(wave_sum(q) * (1.0f / DM) + EPS); }
#pragma unroll
    for (int r = 0; r < NR; ++r)
#pragma unroll
        for (int j = 0; j < 4; ++j) *(f32x4*)(y0 + (size_t)r * DM + 4 * lane + 256 * j) = a[r][j] * sq[r] * gv[j];
}
struct EpiDown {
    float* Y; const bf16_t* HB; unsigned* cnt; const float* fnorm; float* xbuf; LAS float* scr; int fused;
    __device__ __forceinline__ void operator()(const f32x4 (&acc)[2][2][4][2], const pg8::Unit& u, int wr, int wc, int fr, int fq) const {
        const int row0 = u.pm * 256 + wr * 64 + fr, c0 = u.pn * 256 + wc * 32 + fq * 8;
        if (u.pm >= 256) {
#pragma unroll
            for (int ai = 0; ai < 2; ++ai)
#pragma unroll
                for (int m = 0; m < 4; ++m) { const int row = row0 + ai * 128 + m * 16;
#pragma unroll
                    for (int bj = 0; bj < 2; ++bj) { float* yp = Y + (size_t)row * DM + c0 + bj * 128;
#pragma unroll
                        for (int i = 0; i < 4; ++i) { atomicAdd(yp + i, acc[ai][bj][m][0][i]); atomicAdd(yp + 4 + i, acc[ai][bj][m][1][i]); } } }
            return;
        }
        if (!fused) {
#pragma unroll
            for (int ai = 0; ai < 2; ++ai) {
                u32x4 hbv[4][2];
#pragma unroll
                for (int m = 0; m < 4; ++m)
#pragma unroll
                    for (int bj = 0; bj < 2; ++bj) hbv[m][bj] = *(const u32x4*)(HB + (size_t)(row0 + ai * 128 + m * 16) * DM + c0 + bj * 128);
#pragma unroll
                for (int m = 0; m < 4; ++m) { const int row = row0 + ai * 128 + m * 16;
#pragma unroll
                    for (int bj = 0; bj < 2; ++bj) { const u32x4 hb = hbv[m][bj];
                        const f32x4 h0 = acc[ai][bj][m][0] + (f32x4){bflo(hb.x), bfhi(hb.x), bflo(hb.y), bfhi(hb.y)}, h1 = acc[ai][bj][m][1] + (f32x4){bflo(hb.z), bfhi(hb.z), bflo(hb.w), bfhi(hb.w)};
                        *(u32x4*)((bf16_t*)HB + (size_t)row * DM + c0 + bj * 128) = pack8(h0, h1); } }
            }
            return;
        }
#pragma unroll
        for (int ai = 0; ai < 2; ++ai) {
            u32x4 hbv[4][2];
#pragma unroll
            for (int m = 0; m < 4; ++m)
#pragma unroll
                for (int bj = 0; bj < 2; ++bj) hbv[m][bj] = *(const u32x4*)((const char*)HB + ((unsigned)(row0 + ai * 128 + m * 16) * (unsigned)(DM * 2) + (unsigned)(c0 + bj * 128) * 2u));
#pragma unroll
            for (int m = 0; m < 4; ++m) { float q = 0.f;
#pragma unroll
                for (int bj = 0; bj < 2; ++bj) { const u32x4 hb = hbv[m][bj];
                    const f32x4 h0 = acc[ai][bj][m][0] + (f32x4){bflo(hb.x), bfhi(hb.x), bflo(hb.y), bfhi(hb.y)}, h1 = acc[ai][bj][m][1] + (f32x4){bflo(hb.z), bfhi(hb.z), bflo(hb.w), bfhi(hb.w)};
                    q += (h0[0] * h0[0] + h0[1] * h0[1]) + (h0[2] * h0[2] + h0[3] * h0[3]) + (h1[0] * h1[0] + h1[1] * h1[1]) + (h1[2] * h1[2] + h1[3] * h1[3]); }
                q += __shfl_xor(q, 16); q += __shfl_xor(q, 32);
                if (fq == 0) scr[(ai * 128 + wr * 64 + m * 16 + fr) * 4 + wc] = q; }
        }
        asm volatile("s_waitcnt lgkmcnt(0)" ::: "memory");
        __builtin_amdgcn_s_barrier();
        if (threadIdx.x < 256) { const f32x4 p4 = *(const LAS f32x4*)(scr + threadIdx.x * 4);
            __hip_atomic_store(xbuf + ((size_t)u.pm * 256 + threadIdx.x) * 4 + u.pn, (p4[0] + p4[1]) + (p4[2] + p4[3]), __ATOMIC_RELAXED, __HIP_MEMORY_SCOPE_AGENT); }
        asm volatile("s_waitcnt vmcnt(0)" ::: "memory");
        __builtin_amdgcn_s_barrier();
        if (threadIdx.x == 0) {
            __hip_atomic_fetch_add(cnt + u.pm, 1u, __ATOMIC_RELAXED, __HIP_MEMORY_SCOPE_AGENT);
            unsigned spins = 0;
            while (__hip_atomic_load(cnt + u.pm, __ATOMIC_RELAXED, __HIP_MEMORY_SCOPE_AGENT) < 4u && ++spins < (1u << 22)) __builtin_amdgcn_s_sleep(1);
        }
        __builtin_amdgcn_s_barrier();
        if (threadIdx.x < 256) {
            const float* xp = xbuf + ((size_t)u.pm * 256 + threadIdx.x) * 4;
            const float t0 = __hip_atomic_load(xp, __ATOMIC_RELAXED, __HIP_MEMORY_SCOPE_AGENT), t1 = __hip_atomic_load(xp + 1, __ATOMIC_RELAXED, __HIP_MEMORY_SCOPE_AGENT),
                        t2 = __hip_atomic_load(xp + 2, __ATOMIC_RELAXED, __HIP_MEMORY_SCOPE_AGENT), t3 = __hip_atomic_load(xp + 3, __ATOMIC_RELAXED, __HIP_MEMORY_SCOPE_AGENT);
            scr[1024 + threadIdx.x] = rsqrtf(((t0 + t1) + (t2 + t3)) * (1.0f / DM) + EPS); }
        asm volatile("s_waitcnt lgkmcnt(0)" ::: "memory");
        __builtin_amdgcn_s_barrier();
        f32x4 gn[2][2];
#pragma unroll
        for (int bj = 0; bj < 2; ++bj) { gn[bj][0] = *(const f32x4*)(fnorm + c0 + bj * 128); gn[bj][1] = *(const f32x4*)(fnorm + c0 + bj * 128 + 4); }
#pragma unroll
        for (int ai = 0; ai < 2; ++ai) {
            u32x4 hbv[4][2];
#pragma unroll
            for (int m = 0; m < 4; ++m)
#pragma unroll
                for (int bj = 0; bj < 2; ++bj) hbv[m][bj] = *(const u32x4*)((const char*)HB + ((unsigned)(row0 + ai * 128 + m * 16) * (unsigned)(DM * 2) + (unsigned)(c0 + bj * 128) * 2u));
#pragma unroll
            for (int m = 0; m < 4; ++m) { const int row = row0 + ai * 128 + m * 16; const float r = scr[1024 + wr * 64 + fr + ai * 128 + m * 16];
#pragma unroll
                for (int bj = 0; bj < 2; ++bj) { const u32x4 hb = hbv[m][bj]; float* yp = (float*)((char*)Y + ((unsigned)row * (unsigned)(DM * 4) + (unsigned)(c0 + bj * 128) * 4u));
                    const f32x4 h0 = acc[ai][bj][m][0] + (f32x4){bflo(hb.x), bfhi(hb.x), bflo(hb.y), bfhi(hb.y)}, h1 = acc[ai][bj][m][1] + (f32x4){bflo(hb.z), bfhi(hb.z), bflo(hb.w), bfhi(hb.w)};
                    *(f32x4*)yp = h0 * r * gn[bj][0]; *(f32x4*)(yp + 4) = h1 * r * gn[bj][1]; } }
        }
    }
};

__device__ __forceinline__ int map_in(int p) {
    if (p < 2048 || p >= 2688) return p;
    const int q = p - 2048, head = q >> 6, pp = q & 63, wcp = pp >> 5, fq = (pp >> 3) & 3, n = (pp >> 2) & 1, i = pp & 3;
    return 2048 + head * 64 + n * 32 + wcp * 16 + fq * 4 + i;
}
__device__ __forceinline__ int map_ffn(int p) {
    const int G = p >> 5, fq = (p >> 3) & 3, n = (p >> 2) & 1, i = p & 3; return n * DFF + G * 16 + fq * 4 + i;
}
template <int MAP>
__device__ __forceinline__ void p0_transpose_item(const float* W, int K, int N, bf16_t* WT, const float* gain, LAS float* scr, int item, int lane) {
    const int nblk = N / 32, kb = item / nblk, nb = item % nblk, k0 = 64 * kb, n0 = 32 * nb;
    const int pc = n0 + (lane & 31); const int lc = MAP == 1 ? map_in(pc) : (MAP == 2 ? map_ffn(pc) : pc);
    float wv[32];
#pragma unroll
    for (int i = 0; i < 32; ++i) wv[i] = W[(size_t)(k0 + 2 * i + (lane >> 5)) * N + lc];
#pragma unroll
    for (int i = 0; i < 32; ++i) { const int kk = 2 * i + (lane >> 5); float w = wv[i]; if (gain) w *= gain[k0 + kk]; scr[kk * 33 + (lane & 31)] = w; }
    LDS_WAIT(); asm volatile("" ::: "memory");
    const int c = lane & 7;
#pragma unroll
    for (int j = 0; j < 4; ++j) { const int n = (lane >> 3) + 8 * j; const LAS float* s = scr + (8 * c) * 33 + n;
        u32x4 o; o.x = cvt_pk_bf16(s[0 * 33], s[1 * 33]); o.y = cvt_pk_bf16(s[2 * 33], s[3 * 33]); o.z = cvt_pk_bf16(s[4 * 33], s[5 * 33]); o.w = cvt_pk_bf16(s[6 * 33], s[7 * 33]);
        *(u32x4*)(WT + (size_t)(n0 + n) * K + k0 + 8 * c) = o; }
    LDS_WAIT(); asm volatile("" ::: "memory");
}

__device__ __forceinline__ void p0_prologue(const Params& P, LAS unsigned char* lds) {
    const int tid = threadIdx.x, lane = tid & 63, wave = tid >> 6;
    const int gw = blockIdx.x * 8 + wave, NGW = gridDim.x * 8;
    unsigned char* ws = P.ws;
    LAS float* scr = (LAS float*)(lds + wave * 16384);
    constexpr int I_IN = 16 * (NIN / 32), I_OUT = 16 * 32, I_FI = 16 * (NFF2 / 32), I_FO = (DFF / 64) * 32;
    for (int it = gw; it < I_IN + I_OUT + I_FI + I_FO; it += NGW) {
        int r = it;
        if (r < I_IN) { p0_transpose_item<1>(P.in[9], DM, NIN, (bf16_t*)(ws + WS_WIN), nullptr, scr, r, lane); continue; } r -= I_IN;
        if (r < I_OUT) { p0_transpose_item<0>(P.in[14], DM, DM, (bf16_t*)(ws + WS_WOUT), nullptr, scr, r, lane); continue; } r -= I_OUT;
        if (r < I_FI) { p0_transpose_item<2>(P.in[16], DM, NFF2, (bf16_t*)(ws + WS_WFI), P.in[15], scr, r, lane); continue; } r -= I_FI;
        p0_transpose_item<0>(P.in[17], DFF, DM, (bf16_t*)(ws + WS_WFO), nullptr, scr, r, lane);
    }
    {
        const float* g1 = P.in[8]; bf16_t* XN = (bf16_t*)(ws + WS_XN);
        f32x4 gv[4];
#pragma unroll
        for (int j = 0; j < 4; ++j) gv[j] = *(const f32x4*)(g1 + 4 * lane + 256 * j);
        for (int q4 = gw; q4 < RTOT / 4; q4 += NGW) {
            const int r0 = q4 * 4;
            if (r0 >= ROW_END) {
#pragma unroll
                for (int rr = 0; rr < 4; ++rr) { unsigned long long* o8 = (unsigned long long*)(XN + (size_t)(r0 + rr) * DM) + lane;
#pragma unroll
                    for (int j = 0; j < 4; ++j) o8[64 * j] = 0ull; }
                continue; }
            const float* src = r0 < ROW_S ? P.in[0] + (size_t)r0 * DM : (r0 < ROW_M ? P.in[1] + (size_t)(r0 - ROW_S) * DM : P.in[7] + (size_t)(r0 - ROW_M) * DM);
            f32x4 v[4][4]; float sq[4];
#pragma unroll
            for (int rr = 0; rr < 4; ++rr)
#pragma unroll
                for (int j = 0; j < 4; ++j) v[rr][j] = *(const f32x4*)(src + (size_t)rr * DM + 4 * lane + 256 * j);
#pragma unroll
            for (int rr = 0; rr < 4; ++rr) { float s_ = 0.f;
#pragma unroll
                for (int j = 0; j < 4; ++j) s_ += (v[rr][j][0] * v[rr][j][0] + v[rr][j][1] * v[rr][j][1]) + (v[rr][j][2] * v[rr][j][2] + v[rr][j][3] * v[rr][j][3]);
                const float ms_ = wave_sum(s_) * (1.0f / DM) + EPS; sq[rr] = rsqrtf(ms_); if (lane == 0) ((float*)(ws + WS_SS2))[r0 + rr] = sqrtf(ms_); }
#pragma unroll
            for (int rr = 0; rr < 4; ++rr) {
                u32x2 pc[4];
#pragma unroll
                for (int j = 0; j < 4; ++j) { const f32x4 y = v[rr][j] * sq[rr] * gv[j]; pc[j] = pack4(y); }
                bf16_t* xr = XN + (size_t)(r0 + rr) * DM;
#pragma unroll
                for (int j = 0; j < 4; j += 2) { const bool odd = lane & 1;
                    const unsigned sx = odd ? pc[j].x : pc[j + 1].x, sy = odd ? pc[j].y : pc[j + 1].y;
                    const unsigned rx = (unsigned)__shfl_xor((int)sx, 1), ry = (unsigned)__shfl_xor((int)sy, 1);
                    const u32x4 o = odd ? (u32x4){rx, ry, pc[j + 1].x, pc[j + 1].y} : (u32x4){pc[j].x, pc[j].y, rx, ry};
                    *(u32x4*)(xr + 256 * (j + (odd ? 1 : 0)) + 4 * (lane & ~1)) = o; } }
        }
    }
    {
        const int gt = blockIdx.x * 512 + tid, NGT = gridDim.x * 512;
        float* lb = (float*)(ws + WS_LB); float* rope = (float*)(ws + WS_ROPE); float* ss1 = (float*)(ws + WS_SS1);
        if (gt < 512) { const float p0 = P.in[10][gt], p1 = P.in[10][512 + gt]; lb[gt] = 1.0f / (1.0f + expf(p1 - p0)); }
        if (gt < 320) { ((unsigned*)(ws + WS_CTL))[gt] = 0u; }
        if (gt < DM) ((float*)(ws + WS_GINV))[gt] = 1.0f / P.in[8][gt];
        for (int i = gt; i < NPOS * 32; i += NGT) { const int pos = i >> 5, d = i & 31;
            const double inv = exp(-(double)d * (9.210340371976184 / 32.0)), ang = (double)pos * inv;
            rope[2 * i] = (float)cos(ang); rope[2 * i + 1] = (float)sin(ang); }
        for (int i = gt; i < RTOT; i += NGT) ss1[i] = 0.f;
    }
}

constexpr int HG_QD = 0, HG_KD = 17408, HG_QB = 34816, HG_KLT = 52224, HG_VT = 70656, HG_ST = 89088, HG_AM = 123904, HG_SEG = 133120, HG_DL = 137216, HG_RSS = 137728;
constexpr int PK = 272  , PT = 144  ;

__device__ __forceinline__ void hgrn_unit(const Params& P, LAS unsigned char* lds, int kind, int b, int h) {
    const int tid = threadIdx.x, lane = tid & 63, w = __builtin_amdgcn_readfirstlane(tid >> 6), fr = lane & 15, fq = lane >> 4;
    unsigned char* ws = P.ws;
    const bf16_t* QH = (const bf16_t*)(ws + WS_QH); const bf16_t* LF = (const bf16_t*)(ws + WS_LF); const bf16_t* VH = (const bf16_t*)(ws + WS_VH);
    const bf16_t* GH = (const bf16_t*)(ws + WS_GH); bf16_t* MIX = (bf16_t*)(ws + WS_MIX); const float* hgn = P.in[11];
    const int k = tid & 127, seg = tid >> 7;
    const int kp = w & 3, vh = w >> 2;
    f32x4 sacc[2][4];
    if (kind == 0) {
#pragma unroll
        for (int a = 0; a < 2; ++a)
#pragma unroll
            for (int c = 0; c < 4; ++c) sacc[a][c] = (f32x4){0.f, 0.f, 0.f, 0.f};
    } else {
        const float* S0 = P.in[6] + (size_t)(b * 4 + h) * 16384;
#pragma unroll
        for (int a = 0; a < 2; ++a)
#pragma unroll
            for (int c = 0; c < 4; ++c)
#pragma unroll
                for (int j = 0; j < 4; ++j) sacc[a][c][j] = S0[(size_t)((kp * 2 + a) * 16 + fq * 4 + j) * 128 + (vh * 4 + c) * 16 + fr];
    }
    f32x4 gnv[4];
#pragma unroll
    for (int c = 0; c < 4; ++c) gnv[c] = *(const f32x4*)(hgn + h * 128 + (vh * 4 + c) * 16 + fq * 4);
    const int nchunks = kind == 0 ? 33 : 1;
#define BAR_LDS() do { asm volatile("s_waitcnt lgkmcnt(0)" ::: "memory"); __builtin_amdgcn_s_barrier(); asm volatile("" ::: "memory"); } while (0)
#define HG_DESC(ci_, row0_, nvalid_, wout_) do { if (kind == 0) { if ((ci_) == 0) { row0_ = ROW_M; nvalid_ = NMETA; wout_ = false; } else { row0_ = b * SEQ + ((ci_) - 1) * 64; nvalid_ = 64; wout_ = true; } } \
        else { row0_ = ROW_S + b * DSEQ; nvalid_ = DSEQ; wout_ = true; } } while (0)
#define HG_LOAD(ci_) do { int r0_, nv_; bool wo_; HG_DESC(ci_, r0_, nv_, wo_); (void)wo_; \
        if (w * 8 < nv_) { const size_t ro_ = (size_t)(r0_ + w * 8) * 512 + h * 128; const bf16_t* lp_ = LF + ro_; const bf16_t* qp_ = QH + ro_; const bf16_t* vp_ = VH + ro_; \
            _Pragma("unroll") for (int i = 0; i < 8; ++i) { lfr[i] = *(const unsigned*)(lp_ + i * 512 + 2 * lane); qraw[i] = *(const unsigned*)(qp_ + i * 512 + 2 * lane); vraw[i] = *(const unsigned*)(vp_ + i * 512 + 2 * lane); } } \
        else { _Pragma("unroll") for (int i = 0; i < 8; ++i) { lfr[i] = 0u; qraw[i] = 0u; vraw[i] = 0u; } } } while (0)
    unsigned lfr[8], qraw[8], vraw[8];
    f32x4 oa[4]; u32x2 gg[4]; int prow0 = 0, pnvalid = 0; bool pwout = false;
#pragma unroll
    for (int c = 0; c < 4; ++c) { oa[c] = (f32x4){0.f, 0.f, 0.f, 0.f}; gg[c] = (u32x2){0u, 0u}; }
#define HG_READOUT() do { if (pwout) { const int t = (w & 3) * 16 + fr; \
            if (t < pnvalid) { const float tot = ((LAS float*)(lds + HG_RSS))[t * 2] + ((LAS float*)(lds + HG_RSS))[t * 2 + 1]; \
                const float rs = rsqrtf(tot * (1.0f / 128.0f) + EPS); const size_t row = (size_t)(prow0 + t); \
                _Pragma("unroll") for (int c = 0; c < 4; ++c) { const int v0 = h * 128 + (vh * 4 + c) * 16 + fq * 4; const f32x4 gn = gnv[c]; \
                    f32x4 y; y[0] = oa[c][0] * rs * gn[0] * bflo(gg[c].x); y[1] = oa[c][1] * rs * gn[1] * bfhi(gg[c].x); \
                    y[2] = oa[c][2] * rs * gn[2] * bflo(gg[c].y); y[3] = oa[c][3] * rs * gn[3] * bfhi(gg[c].y); \
                    *(u32x2*)(MIX + row * DM + v0) = pack4(y); } } } } while (0)
    HG_LOAD(0);
    for (int ci = 0; ci < nchunks; ++ci) {
        int row0, nvalid; bool wout; HG_DESC(ci, row0, nvalid, wout);
        f32x2 lf[8]; unsigned qr[8], vr[8];
#pragma unroll
        for (int i = 0; i < 8; ++i) { const f16x2 hh = __builtin_bit_cast(f16x2, lfr[i]); lf[i].x = (float)hh.x; lf[i].y = (float)hh.y; qr[i] = qraw[i]; vr[i] = vraw[i]; }
        if (ci + 1 < nchunks) HG_LOAD(ci + 1);
        f32x2 cs[8]; { f32x2 a = (f32x2){0.f, 0.f};
#pragma unroll
            for (int i = 0; i < 8; ++i) { a = a + lf[i]; cs[i] = a; } }
        *(LAS f32x2*)(lds + HG_SEG + (w * 128 + 2 * lane) * 4) = cs[7];
        BAR_LDS();
        f32x2 pre = (f32x2){0.f, 0.f}, bm = (f32x2){0.f, 0.f}, bL;
        { f32x2 hi = (f32x2){0.f, 0.f};
#pragma unroll
            for (int sgi = 0; sgi < 8; ++sgi) { const f32x2 sv = *(const LAS f32x2*)(lds + HG_SEG + (sgi * 128 + 2 * lane) * 4);
                if (sgi < w) pre = pre + sv;
                if (sgi < 4) bm = bm + sv; else hi = hi + sv; }
            bL = bm + hi; }
        f32x2 em, elm; em.x = __builtin_amdgcn_exp2f(bm.x); em.y = __builtin_amdgcn_exp2f(bm.y); elm.x = __builtin_amdgcn_exp2f(bL.x - bm.x); elm.y = __builtin_amdgcn_exp2f(bL.y - bm.y);
        if (w == 0) { f32x2 dl; dl.x = __builtin_amdgcn_exp2f(bL.x); dl.y = __builtin_amdgcn_exp2f(bL.y); *(LAS f32x2*)(lds + HG_DL + 2 * lane * 4) = dl; }
        f32x2 klv[8];
#pragma unroll
        for (int i = 0; i < 8; ++i) { const int t = w * 8 + i;
            const f32x2 d = (pre + cs[i]) - bm;
            f32x2 e1, r1, kk, q;
            e1.x = __builtin_amdgcn_exp2f(d.x); e1.y = __builtin_amdgcn_exp2f(d.y); r1.x = __builtin_amdgcn_exp2f(-d.x); r1.y = __builtin_amdgcn_exp2f(-d.y);
            kk.x = 1.0f - __builtin_amdgcn_exp2f(lf[i].x); kk.y = 1.0f - __builtin_amdgcn_exp2f(lf[i].y);
            q.x = bflo(qr[i]); q.y = bfhi(qr[i]);
            const f32x2 qd = q * e1, kd = kk * r1, qb = qd * em; klv[i] = kd * elm;
            *(LAS unsigned*)(lds + HG_QD + t * PK + lane * 4) = cvt_pk_bf16(qd.x, qd.y);
            *(LAS unsigned*)(lds + HG_KD + t * PK + lane * 4) = cvt_pk_bf16(kd.x, kd.y);
            *(LAS unsigned*)(lds + HG_QB + t * PK + lane * 4) = cvt_pk_bf16(qb.x, qb.y); }
        {
            u32x4 k0, k1, v0, v1;
            k0.x = cvt_pk_bf16(klv[0].x, klv[1].x); k0.y = cvt_pk_bf16(klv[2].x, klv[3].x); k0.z = cvt_pk_bf16(klv[4].x, klv[5].x); k0.w = cvt_pk_bf16(klv[6].x, klv[7].x);
            k1.x = cvt_pk_bf16(klv[0].y, klv[1].y); k1.y = cvt_pk_bf16(klv[2].y, klv[3].y); k1.z = cvt_pk_bf16(klv[4].y, klv[5].y); k1.w = cvt_pk_bf16(klv[6].y, klv[7].y);
            v0.x = __builtin_amdgcn_perm(vr[1], vr[0], 0x05040100u); v0.y = __builtin_amdgcn_perm(vr[3], vr[2], 0x05040100u); v0.z = __builtin_amdgcn_perm(vr[5], vr[4], 0x05040100u); v0.w = __builtin_amdgcn_perm(vr[7], vr[6], 0x05040100u);
            v1.x = __builtin_amdgcn_perm(vr[1], vr[0], 0x07060302u); v1.y = __builtin_amdgcn_perm(vr[3], vr[2], 0x07060302u); v1.z = __builtin_amdgcn_perm(vr[5], vr[4], 0x07060302u); v1.w = __builtin_amdgcn_perm(vr[7], vr[6], 0x07060302u);
            *(LAS u32x4*)(lds + HG_KLT + (2 * lane) * PT + w * 16) = k0; *(LAS u32x4*)(lds + HG_KLT + (2 * lane + 1) * PT + w * 16) = k1;
            *(LAS u32x4*)(lds + HG_VT + (2 * lane) * PT + w * 16) = v0; *(LAS u32x4*)(lds + HG_VT + (2 * lane + 1) * PT + w * 16) = v1;
        }
        HG_READOUT();
        prow0 = row0; pnvalid = nvalid; pwout = wout;
        { const int t = (w & 3) * 16 + fr;
#pragma unroll
            for (int c = 0; c < 4; ++c) gg[c] = *(const u32x2*)(GH + (size_t)(row0 + t) * 512 + h * 128 + (vh * 4 + c) * 16 + fq * 4); }
#pragma unroll
        for (int a = 0; a < 2; ++a)
#pragma unroll
            for (int c = 0; c < 4; ++c) { const int kk0 = (kp * 2 + a) * 16 + fq * 4, v = (vh * 4 + c) * 16 + fr;
                *(LAS u32x2*)(lds + HG_ST + v * PK + kk0 * 2) = pack4(sacc[a][c]); }
        BAR_LDS();
        {
            const int st = w & 3, tt0 = (w >> 2) * 2;
            f32x4 aa[2] = {(f32x4){0.f, 0.f, 0.f, 0.f}, (f32x4){0.f, 0.f, 0.f, 0.f}};
#pragma unroll
            for (int kk = 0; kk < 4; ++kk) { const bf16x8 af = *(const LAS bf16x8*)(lds + HG_KD + (st * 16 + fr) * PK + kk * 64 + fq * 16);
#pragma unroll
                for (int e = 0; e < 2; ++e) { const bf16x8 bfq = *(const LAS bf16x8*)(lds + HG_QD + ((tt0 + e) * 16 + fr) * PK + kk * 64 + fq * 16);
                    aa[e] = __builtin_amdgcn_mfma_f32_16x16x32_bf16(af, bfq, aa[e], 0, 0, 0); } }
#pragma unroll
            for (int e = 0; e < 2; ++e) { const int t = (tt0 + e) * 16 + fr, sb = st * 16 + fq * 4; f32x4 m;
#pragma unroll
                for (int j = 0; j < 4; ++j) m[j] = (sb + j <= t) ? aa[e][j] : 0.f;
                *(LAS u32x2*)(lds + HG_AM + t * PT + sb * 2) = pack4(m); }
        }
        BAR_LDS();
        const int tt = w & 3;
        {
#pragma unroll
            for (int c = 0; c < 4; ++c) oa[c] = (f32x4){0.f, 0.f, 0.f, 0.f};
#pragma unroll
            for (int kk = 0; kk < 4; ++kk) { const bf16x8 bq = *(const LAS bf16x8*)(lds + HG_QB + (tt * 16 + fr) * PK + kk * 64 + fq * 16);
#pragma unroll
                for (int c = 0; c < 4; ++c) { const bf16x8 af = *(const LAS bf16x8*)(lds + HG_ST + ((vh * 4 + c) * 16 + fr) * PK + kk * 64 + fq * 16);
                    oa[c] = __builtin_amdgcn_mfma_f32_16x16x32_bf16(af, bq, oa[c], 0, 0, 0); } }
#pragma unroll
            for (int ss = 0; ss < 2; ++ss) { const bf16x8 bq = *(const LAS bf16x8*)(lds + HG_AM + (tt * 16 + fr) * PT + ss * 64 + fq * 16);
#pragma unroll
                for (int c = 0; c < 4; ++c) { const bf16x8 af = *(const LAS bf16x8*)(lds + HG_VT + ((vh * 4 + c) * 16 + fr) * PT + ss * 64 + fq * 16);
                    oa[c] = __builtin_amdgcn_mfma_f32_16x16x32_bf16(af, bq, oa[c], 0, 0, 0); } }
            float q = 0.f;
#pragma unroll
            for (int c = 0; c < 4; ++c) q += (oa[c][0] * oa[c][0] + oa[c][1] * oa[c][1]) + (oa[c][2] * oa[c][2] + oa[c][3] * oa[c][3]);
            q += __shfl_xor(q, 16); q += __shfl_xor(q, 32);
            if (fq == 0) ((LAS float*)(lds + HG_RSS))[(tt * 16 + fr) * 2 + vh] = q;
        }
        {
#pragma unroll
            for (int a = 0; a < 2; ++a) { const f32x4 dl = *(const LAS f32x4*)(lds + HG_DL + ((kp * 2 + a) * 16 + fq * 4) * 4);
#pragma unroll
                for (int c = 0; c < 4; ++c) sacc[a][c] = sacc[a][c] * dl; }
#pragma unroll
            for (int t2 = 0; t2 < 2; ++t2) {
                bf16x8 af[2], bv[4];
#pragma unroll
                for (int a = 0; a < 2; ++a) af[a] = *(const LAS bf16x8*)(lds + HG_KLT + ((kp * 2 + a) * 16 + fr) * PT + t2 * 64 + fq * 16);
#pragma unroll
                for (int c = 0; c < 4; ++c) bv[c] = *(const LAS bf16x8*)(lds + HG_VT + ((vh * 4 + c) * 16 + fr) * PT + t2 * 64 + fq * 16);
#pragma unroll
                for (int a = 0; a < 2; ++a)
#pragma unroll
                    for (int c = 0; c < 4; ++c) sacc[a][c] = __builtin_amdgcn_mfma_f32_16x16x32_bf16(af[a], bv[c], sacc[a][c], 0, 0, 0);
            }
        }
    }
    BAR_LDS();
    HG_READOUT();
    float* so = P.out + (kind == 0 ? OFF_PST : OFF_SST) + (size_t)(b * 4 + h) * 16384;
#pragma unroll
    for (int a = 0; a < 2; ++a)
#pragma unroll
        for (int c = 0; c < 4; ++c)
#pragma unroll
            for (int j = 0; j < 4; ++j) so[(size_t)((kp * 2 + a) * 16 + fq * 4 + j) * 128 + (vh * 4 + c) * 16 + fr] = sacc[a][c][j];
    __syncthreads();
}

constexpr int AT_K = 0, AT_V = 56576;
constexpr int PKA = 272, PVA = 472;

__device__ __forceinline__ void attn_unit(const Params& P, LAS unsigned char* lds, int kind, int b, int c) {
    const int tid = threadIdx.x, lane = tid & 63, w = __builtin_amdgcn_readfirstlane(tid >> 6), fr = lane & 15, fq = lane >> 4;
    unsigned char* ws = P.ws;
    const bf16_t* AQ = (const bf16_t*)(ws + WS_AQ); const bf16_t* AK = (const bf16_t*)(ws + WS_AK); const bf16_t* AV = (const bf16_t*)(ws + WS_AV);
    bf16_t* MIX = (bf16_t*)(ws + WS_MIX);
    const int nqt = kind == 0 ? 2 : 1;
    const int tl = fr >> 2, hr = fr & 3;
    bf16x8 qf[2][2][2];
#pragma unroll
    for (int qt = 0; qt < 2; ++qt) { const int t = kind == 0 ? w * 8 + qt * 4 + tl : w * 4 + tl;
        const size_t row = kind == 0 ? (size_t)b * SEQ + c * 64 + t : (size_t)ROW_S + b * DSEQ + t;
#pragma unroll
        for (int g = 0; g < 2; ++g)
#pragma unroll
            for (int dd = 0; dd < 2; ++dd) qf[qt][g][dd] = (qt < nqt) ? *(const bf16x8*)(AQ + row * 512 + (g * 4 + hr) * 64 + dd * 32 + fq * 8) : (bf16x8){0, 0, 0, 0, 0, 0, 0, 0}; }
    __syncthreads();
    {
        u32x4 kq[7], vq[7];
#pragma unroll
        for (int it = 0; it < 7; ++it) {
            kq[it] = (u32x4){0u, 0u, 0u, 0u}; vq[it] = (u32x4){0u, 0u, 0u, 0u};
            const int idx = tid + it * 512, jk = idx >> 4, pck = idx & 15;
            const int jv = it * 32 + (lane & 31), pcv = w * 2 + (lane >> 5);
            if (kind == 0) {
                int rk = -1, rv = -1;
                if (jk < 16) rk = ROW_M + jk; else if (jk < 208) { const int sq = (c - 2) * 64 + (jk - 16); if (sq >= 0) rk = b * SEQ + sq; }
                if (jv < 16) rv = ROW_M + jv; else if (jv < 208) { const int sq = (c - 2) * 64 + (jv - 16); if (sq >= 0) rv = b * SEQ + sq; }
                const u32x4 kl = *(const u32x4*)(AK + (size_t)(rk >= 0 ? rk : 0) * 128 + pck * 8), vl = *(const u32x4*)(AV + (size_t)(rv >= 0 ? rv : 0) * 128 + pcv * 8);
                if (rk >= 0) kq[it] = kl;
                if (rv >= 0) vq[it] = vl;
            } else {
                if (jk < 144) { const float* kp_ = jk < 16 ? P.in[2] + (size_t)(b * 16 + jk) * 128 : P.in[4] + (size_t)(b * 128 + jk - 16) * 128;
                    kq[it] = pack8(*(const f32x4*)(kp_ + pck * 8), *(const f32x4*)(kp_ + pck * 8 + 4)); }
                else if (jk < 176) kq[it] = *(const u32x4*)(AK + (size_t)(ROW_S + b * DSEQ + (jk - 144)) * 128 + pck * 8);
                if (jv < 144) { const float* vp_ = jv < 16 ? P.in[3] + (size_t)(b * 16 + jv) * 128 : P.in[5] + (size_t)(b * 128 + jv - 16) * 128;
                    vq[it] = pack8(*(const f32x4*)(vp_ + pcv * 8), *(const f32x4*)(vp_ + pcv * 8 + 4)); }
                else if (jv < 176) vq[it] = *(const u32x4*)(AV + (size_t)(ROW_S + b * DSEQ + (jv - 144)) * 128 + pcv * 8);
            }
        }
#pragma unroll
        for (int it = 0; it < 7; ++it) {
            const int idx = tid + it * 512, jk = idx >> 4, pck = idx & 15;
            const int jv = it * 32 + (lane & 31), pcv = w * 2 + (lane >> 5);
            if (jk < 208) *(LAS u32x4*)(lds + AT_K + jk * PKA + pck * 16) = kq[it];
#pragma unroll
            for (int e = 0; e < 4; ++e) { const unsigned u = vq[it][e];
                *(LAS bf16_t*)(lds + AT_V + (pcv * 8 + 2 * e) * PVA + jv * 2) = (bf16_t)(u & 0xffffu);
                *(LAS bf16_t*)(lds + AT_V + (pcv * 8 + 2 * e + 1) * PVA + jv * 2) = (bf16_t)(u >> 16); }
        }
    }
    __syncthreads();
    unsigned vmask;
    if (kind == 0) vmask = 0x1u | (c >= 2 ? 0x1eu : 0u) | (c >= 1 ? 0x1e0u : 0u) | 0x1e00u; else vmask = 0x7ffu;
    const float* sinks = P.in[12]; const float* an = P.in[13];
    for (int qt = 0; qt < nqt; ++qt) {
        const int t = kind == 0 ? w * 8 + qt * 4 + tl : w * 4 + tl;
        const size_t row = kind == 0 ? (size_t)b * SEQ + c * 64 + t : (size_t)ROW_S + b * DSEQ + t;
        f32x4 oacc[2][4];
#pragma unroll
        for (int g = 0; g < 2; ++g) {
            bf16x8 qsel[2];
#pragma unroll
            for (int dd = 0; dd < 2; ++dd) qsel[dd] = qt == 0 ? qf[0][g][dd] : qf[1][g][dd];
            f32x4 sa[13];
#pragma unroll
            for (int kt = 0; kt < 13; ++kt) { sa[kt] = (f32x4){0.f, 0.f, 0.f, 0.f};
#pragma unroll
                for (int dd = 0; dd < 2; ++dd) { const bf16x8 kf = *(const LAS bf16x8*)(lds + AT_K + (kt * 16 + fr) * PKA + g * 128 + dd * 64 + fq * 16);
                    sa[kt] = __builtin_amdgcn_mfma_f32_16x16x32_bf16(kf, qsel[dd], sa[kt], 0, 0, 0); } }
            const float sink = sinks[g * 4 + hr] * LOG2E;
            float mx = sink;
#pragma unroll
            for (int kt = 0; kt < 13; ++kt) { const float nb = ((vmask >> kt) & 1u) ? 0.f : -1e30f;
                sa[kt] = sa[kt] + nb;
                mx = fmaxf(fmaxf(mx, fmaxf(sa[kt][0], sa[kt][1])), fmaxf(sa[kt][2], sa[kt][3])); }
            mx = fmaxf(mx, __shfl_xor(mx, 16)); mx = fmaxf(mx, __shfl_xor(mx, 32));
            float sum = 0.f;
#pragma unroll
            for (int kt = 0; kt < 13; ++kt) {
#pragma unroll
                for (int j = 0; j < 4; ++j) sa[kt][j] = __builtin_amdgcn_exp2f(sa[kt][j] - mx);
                sum += (sa[kt][0] + sa[kt][1]) + (sa[kt][2] + sa[kt][3]);
            }
            sum += __shfl_xor(sum, 16); sum += __shfl_xor(sum, 32);
            const float inv = 1.0f / (sum + __builtin_amdgcn_exp2f(sink - mx));
            bf16x8 pb[7];
#pragma unroll
            for (int kp = 0; kp < 7; ++kp) { const f32x4 p0 = sa[2 * kp], p1 = (2 * kp + 1 < 13) ? sa[(2 * kp + 1 < 13) ? 2 * kp + 1 : 0] : (f32x4){0.f, 0.f, 0.f, 0.f};
                const u32x4 u = pack8(p0, p1); pb[kp] = __builtin_bit_cast(bf16x8, u); }
#pragma unroll
            for (int dt = 0; dt < 4; ++dt) { oacc[g][dt] = (f32x4){0.f, 0.f, 0.f, 0.f};
#pragma unroll
                for (int kp = 0; kp < 7; ++kp) {
                    const s16x4 v0 = *(const LAS s16x4*)(lds + AT_V + (g * 64 + dt * 16 + fr) * PVA + (2 * kp) * 32 + fq * 8);
                    const s16x4 v1 = *(const LAS s16x4*)(lds + AT_V + (g * 64 + dt * 16 + fr) * PVA + (2 * kp + 1) * 32 + fq * 8);
                    const bf16x8 vf = __builtin_shufflevector(v0, v1, 0, 1, 2, 3, 4, 5, 6, 7);
                    oacc[g][dt] = __builtin_amdgcn_mfma_f32_16x16x32_bf16(vf, pb[kp], oacc[g][dt], 0, 0, 0); }
                oacc[g][dt] = oacc[g][dt] * inv; }
        }
        float ss = 0.f;
#pragma unroll
        for (int g = 0; g < 2; ++g)
#pragma unroll
            for (int dt = 0; dt < 4; ++dt) ss += (oacc[g][dt][0] * oacc[g][dt][0] + oacc[g][dt][1] * oacc[g][dt][1]) + (oacc[g][dt][2] * oacc[g][dt][2] + oacc[g][dt][3] * oacc[g][dt][3]);
        ss += __shfl_xor(ss, 16); ss += __shfl_xor(ss, 32); ss += __shfl_xor(ss, 1); ss += __shfl_xor(ss, 2);
        const float rs = rsqrtf(ss * (1.0f / 512.0f) + EPS);
#pragma unroll
        for (int g = 0; g < 2; ++g)
#pragma unroll
            for (int dt = 0; dt < 4; ++dt) { const int col = (g * 4 + hr) * 64 + dt * 16 + fq * 4; const f32x4 gn = *(const f32x4*)(an + col);
                const f32x4 y = oacc[g][dt] * rs * gn;
                *(u32x2*)(MIX + row * DM + 512 + col) = pack4(y); }
    }
}

__device__ __forceinline__ void p2_phase(const Params& P, LAS unsigned char* lds, int rep, bool do_hgrn, bool do_attn) {
    unsigned char* ws = P.ws; const int G = gridDim.x, bid = blockIdx.x;
    if (do_hgrn) {
        {
            const bf16_t* AK = (const bf16_t*)(ws + WS_AK); const bf16_t* AV = (const bf16_t*)(ws + WS_AV);
            constexpr int NPW = NBATCH * 128 * 16, NSN = DBATCH * DSEQ * 16, NPM = NBATCH * NMETA * 16;
            for (int i = bid * 512 + threadIdx.x; i < NPW + NSN + NPM; i += G * 512) {
                int src_row; size_t dk, dv; const int pc = i & 15;
                if (i < NPW) { const int r = i >> 4, b = r >> 7, s = r & 127; src_row = b * SEQ + (SEQ - 128) + s; dk = OFF_PWK + (size_t)r * 128; dv = OFF_PWV + (size_t)r * 128; }
                else if (i < NPW + NSN) { const int r = (i - NPW) >> 4; src_row = ROW_S + r; dk = OFF_SNK + (size_t)r * 128; dv = OFF_SNV + (size_t)r * 128; }
                else { const int r = (i - NPW - NSN) >> 4, m = r & 15; src_row = ROW_M + m; dk = OFF_PMK + (size_t)r * 128; dv = OFF_PMV + (size_t)r * 128; }
                const u32x4 kq = *(const u32x4*)(AK + (size_t)src_row * 128 + pc * 8), vq = *(const u32x4*)(AV + (size_t)src_row * 128 + pc * 8);
                float* ko = P.out + dk + pc * 8; float* vo = P.out + dv + pc * 8;
                *(f32x4*)ko = (f32x4){bflo(kq.x), bfhi(kq.x), bflo(kq.y), bfhi(kq.y)}; *(f32x4*)(ko + 4) = (f32x4){bflo(kq.z), bfhi(kq.z), bflo(kq.w), bfhi(kq.w)};
                *(f32x4*)vo = (f32x4){bflo(vq.x), bfhi(vq.x), bflo(vq.y), bfhi(vq.y)}; *(f32x4*)(vo + 4) = (f32x4){bflo(vq.z), bfhi(vq.z), bflo(vq.w), bfhi(vq.w)};
            }
        }
    }
    {
        if (do_hgrn) for (int u = bid; u < 160; u += G) hgrn_unit(P, lds, u < 128 ? 0 : 1, u < 128 ? (u >> 2) : ((u - 128) >> 2), u & 3);
        unsigned* ctr = (unsigned*)(ws + WS_CTL) + rep;
        LAS unsigned* slot = (LAS unsigned*)(lds + LDS_BYTES - 64);
        if (do_attn) for (;;) {
            __syncthreads();
            if (threadIdx.x == 0) *slot = atomicAdd(ctr, 1u);
            __syncthreads();
            const unsigned u = *slot;
            if (u >= 8u + 1024u) break;
            if (u < 8u) attn_unit(P, lds, 1, (int)u, 0); else attn_unit(P, lds, 0, (int)((u - 8u) >> 5), (int)((u - 8u) & 31u));
        }
    }
}

#define XB_TMO      128
#define XB_XCNT(j)  (256  + 64 * (j))
#define XB_XSUB(j)  (1280 + 64 * (j))
#define XB_XGEN(j)  (2304 + 64 * (j))
#define XB_TOP      3328
#define XB_TOPGEN   3392
#define XCD_BAR_WORDS 3456
#define XB_SPIN_CAP (1u << 18)
static_assert(XCD_BAR_WORDS * 4 <= WS_BAR_BYTES, "barrier words");
__device__ __forceinline__ unsigned xb_ld(unsigned* p)              { return __hip_atomic_load(p, __ATOMIC_RELAXED, __HIP_MEMORY_SCOPE_AGENT); }
__device__ __forceinline__ unsigned xb_add(unsigned* p, unsigned v) { return __hip_atomic_fetch_add(p, v, __ATOMIC_RELAXED, __HIP_MEMORY_SCOPE_AGENT); }
__device__ __forceinline__ unsigned xb_xcc_id() { return (unsigned)__builtin_amdgcn_s_getreg((3 << 11) | 20) & 0xFu; }
#define XB_SPIN(cond, bar) do { unsigned _sp = 0; while (cond) { __builtin_amdgcn_s_sleep(1); \
    if ((++_sp & 255u) == 0u) { if (xb_ld(&(bar)[XB_TMO])) break; if (_sp > XB_SPIN_CAP) { atomicAdd(&(bar)[XB_TMO], 1u); break; } } } } while (0)
struct XcdBarrier { unsigned* bar; unsigned x; volatile LAS unsigned* st; };
__device__ __forceinline__ XcdBarrier xcd_barrier_post(unsigned* bar, volatile LAS unsigned* st) {
    XcdBarrier b; b.bar = bar; b.x = xb_xcc_id(); b.st = st;
    if (threadIdx.x == 0) (void)xb_add(&bar[XB_XCNT(b.x)], 1u);
    return b;
}
__device__ __forceinline__ void xcd_barrier_complete(unsigned* bar, unsigned x, unsigned& nloc, unsigned& nx) {
    const unsigned G = gridDim.x * gridDim.y * gridDim.z;
    unsigned sum, cnt, mine, sp = 0u;
    for (;;) {
        sum = 0u; cnt = 0u; mine = 0u;
#pragma unroll
        for (unsigned j = 0; j < 16; ++j) { const unsigned c = xb_ld(&bar[XB_XCNT(j)]); sum += c; cnt += (c > 0u) ? 1u : 0u; mine = (j == x) ? c : mine; }
        if (sum == G) break;
        __builtin_amdgcn_s_sleep(1);
        if ((++sp & 255u) == 0u) { if (xb_ld(&bar[XB_TMO])) break; if (sp > XB_SPIN_CAP) { atomicAdd(&bar[XB_TMO], 1u); break; } }
    }
    nloc = mine > 0u ? mine : 1u; nx = cnt > 0u ? cnt : 1u;
}
__device__ __forceinline__ void xcd_barrier(const XcdBarrier& b) {
    asm volatile("s_waitcnt vmcnt(0)" ::: "memory");
    __syncthreads();
    if (threadIdx.x == 0) {
        unsigned* bar = b.bar;
        __builtin_amdgcn_s_waitcnt(0);
        unsigned nloc = b.st[0], nx = b.st[1];
        if (nloc == 0u) { xcd_barrier_complete(bar, b.x, nloc, nx); b.st[0] = nloc; b.st[1] = nx; }
        const unsigned old = xb_add(&bar[XB_XSUB(b.x)], 1u);
        const unsigned gen = old / nloc;
        if (old + 1u == (gen + 1u) * nloc) {
            __builtin_amdgcn_fence(__ATOMIC_RELEASE, "agent");
            asm volatile("s_waitcnt vmcnt(0)" ::: "memory");
            const unsigned og = xb_add(&bar[XB_TOP], 1u);
            const unsigned tg = og / nx;
            if (og + 1u == (tg + 1u) * nx) xb_add(&bar[XB_TOPGEN], 1u);
            else XB_SPIN(xb_ld(&bar[XB_TOPGEN]) == tg, bar);
            __builtin_amdgcn_fence(__ATOMIC_ACQUIRE, "agent");
            xb_add(&bar[XB_XGEN(b.x)], 1u);
            asm volatile("s_waitcnt vmcnt(0)" ::: "memory");
        } else {
            XB_SPIN(xb_ld(&bar[XB_XGEN(b.x)]) == gen, bar);
            __builtin_amdgcn_fence(__ATOMIC_ACQUIRE, "agent");
            asm volatile("s_waitcnt vmcnt(0)" ::: "memory");
        }
    }
    __syncthreads();
}

__global__ void __launch_bounds__(512, 2) hymba_fwd(Params P) {
    extern __shared__ __attribute__((aligned(16))) unsigned char smem[];
    LAS unsigned char* lds = (LAS unsigned char*)smem;
    cg::grid_group grid = cg::this_grid();
    unsigned char* ws = P.ws;
    const int G = gridDim.x, bid = blockIdx.x;
    volatile LAS unsigned* xst = (volatile LAS unsigned*)(lds + LDS_BYTES - 32);
    if (threadIdx.x == 0) { xst[0] = 0u; xst[1] = 0u; }
    __syncthreads();
    const XcdBarrier xbar = xcd_barrier_post((unsigned*)(ws + WS_BAR), xst);

    p0_prologue(P, lds);
    xcd_barrier(xbar);

    {
        pg8::Gemm g{(const bf16_t*)(ws + WS_XN), (const bf16_t*)(ws + WS_WIN), RTOT, NIN, DM}; pg8::StaticOrder S; S.init(RTOT, NIN, DM, G, bid);
        EpiIn E{ws, P.out};
#pragma unroll 1
        for (int rep = 0; rep < REP_P1; ++rep) { pg8::gemm_phase<EpiIn, pg8::StaticOrder>(lds, g, S, E); if (rep + 1 < REP_P1) grid.sync(); }
    }
    xcd_barrier(xbar);

    p2_phase(P, lds, 0, true, true);
#if REP_P2 > 1
    grid.sync();
    p2_phase(P, lds, 1, false, true);
#endif
    xcd_barrier(xbar);

    {
        pg8::Gemm g{(const bf16_t*)(ws + WS_MIX), (const bf16_t*)(ws + WS_WOUT), MROWS, DM, DM}; pg8::StaticOrder S; S.init(MROWS, DM, DM, G, bid);
        EpiOut E{(bf16_t*)(ws + WS_XN), (float*)(ws + WS_SS1), (const float*)(ws + WS_SS2), (const float*)(ws + WS_GINV)};
        pg8::gemm_phase<EpiOut, pg8::StaticOrder>(lds, g, S, E);
    }
    xcd_barrier(xbar);

    {
        {
            const bf16_t* HBs = (const bf16_t*)(ws + WS_XN) + (size_t)ROW_S * DM; float* Ys = P.out + OFF_Y + (size_t)ROW_S * DM;
            int t2 = threadIdx.x; asm volatile("" : "+v"(t2));
            for (int i = bid * 512 + t2; i < DBATCH * DSEQ * DM / 8; i += G * 512) { const u32x4 hb = *(const u32x4*)(HBs + (size_t)i * 8);
                *(f32x4*)(Ys + (size_t)i * 8) = (f32x4){bflo(hb.x), bfhi(hb.x), bflo(hb.y), bfhi(hb.y)}; *(f32x4*)(Ys + (size_t)i * 8 + 4) = (f32x4){bflo(hb.z), bfhi(hb.z), bflo(hb.w), bfhi(hb.w)}; }
        }
        pg8::Gemm g{(const bf16_t*)(ws + WS_XN), (const bf16_t*)(ws + WS_WFI), MROWS, NFF2, DM}; pg8::StaticOrder S; S.init(MROWS, NFF2, DM, G, bid);
        EpiSwi E{(bf16_t*)(ws + WS_ACT), (float*)(ws + WS_SS1)};
#pragma unroll 1
        for (int rep = 0; rep < REP_P4; ++rep) { pg8::gemm_phase<EpiSwi, pg8::StaticOrder>(lds, g, S, E); if (rep + 1 < REP_P4) grid.sync(); }
    }
    xcd_barrier(xbar);

    {
        pg8::Gemm g{(const bf16_t*)(ws + WS_ACT), (const bf16_t*)(ws + WS_WFO), MROWS, DM, DFF}; pg8::DownOrder S; S.init(G, bid);
        const int fused = (G == 256) ? 1 : 0;
        EpiDown E{P.out + OFF_Y, (const bf16_t*)(ws + WS_XN), (unsigned*)(ws + WS_CTL) + 16, P.in[18], (float*)(ws + WS_MIX), (LAS float*)(lds + 131072), fused};
        pg8::gemm_phase<EpiDown, pg8::DownOrder>(lds, g, S, E);
        {
            xcd_barrier(xbar);
            int t2 = threadIdx.x; asm volatile("" : "+v"(t2));
            const int lane = t2 & 63, gw = bid * 8 + (t2 >> 6), NGW = G * 8;
            f32x4 gv[4];
#pragma unroll
            for (int j = 0; j < 4; ++j) gv[j] = *(const f32x4*)(P.in[18] + 4 * lane + 256 * j);
            for (int r4 = ROW_S / 4 + gw; r4 < MROWS / 4; r4 += NGW) norm_rows<4>(P.out + OFF_Y + (size_t)r4 * 4 * DM, gv, lane);
            if (!fused) {
                const bf16_t* H2 = (const bf16_t*)(ws + WS_XN); float* Yp = P.out + OFF_Y;
                f32x4 fg[2][2];
#pragma unroll
                for (int hh = 0; hh < 2; ++hh) { fg[hh][0] = *(const f32x4*)(P.in[18] + hh * 512 + 8 * lane); fg[hh][1] = *(const f32x4*)(P.in[18] + hh * 512 + 8 * lane + 4); }
                for (int r4 = gw; r4 < ROW_S / 4; r4 += NGW) {
                    u32x4 hb[4][2];
#pragma unroll
                    for (int rr = 0; rr < 4; ++rr)
#pragma unroll
                        for (int hh = 0; hh < 2; ++hh) hb[rr][hh] = *(const u32x4*)(H2 + (size_t)(r4 * 4 + rr) * DM + hh * 512 + 8 * lane);
#pragma unroll
                    for (int rr = 0; rr < 4; ++rr) { f32x4 v[2][2]; float q = 0.f;
#pragma unroll
                        for (int hh = 0; hh < 2; ++hh) { v[hh][0] = (f32x4){bflo(hb[rr][hh].x), bfhi(hb[rr][hh].x), bflo(hb[rr][hh].y), bfhi(hb[rr][hh].y)}; v[hh][1] = (f32x4){bflo(hb[rr][hh].z), bfhi(hb[rr][hh].z), bflo(hb[rr][hh].w), bfhi(hb[rr][hh].w)};
                            q += (v[hh][0][0] * v[hh][0][0] + v[hh][0][1] * v[hh][0][1]) + (v[hh][0][2] * v[hh][0][2] + v[hh][0][3] * v[hh][0][3]) + (v[hh][1][0] * v[hh][1][0] + v[hh][1][1] * v[hh][1][1]) + (v[hh][1][2] * v[hh][1][2] + v[hh][1][3] * v[hh][1][3]); }
                        const float rs = rsqrtf(wave_sum(q) * (1.0f / DM) + EPS);
                        float* yr = Yp + (size_t)(r4 * 4 + rr) * DM + 8 * lane;
#pragma unroll
                        for (int hh = 0; hh < 2; ++hh) { *(f32x4*)(yr + hh * 512) = v[hh][0] * rs * fg[hh][0]; *(f32x4*)(yr + hh * 512 + 4) = v[hh][1] * rs * fg[hh][1]; } }
                }
            }
        }
    }

}

extern "C" void kernel_launch(void* const* d_in, const int* in_sizes, int n_in, void* d_out, int out_size, void* d_ws, size_t ws_size, hipStream_t stream) {
    static int grid = 0;
    if (grid == 0) {
        int dev = 0, cus = 0, per_cu = 0;
        hipGetDevice(&dev);
        hipDeviceGetAttribute(&cus, hipDeviceAttributeMultiprocessorCount, dev);
        hipFuncSetAttribute((const void*)hymba_fwd, hipFuncAttributeMaxDynamicSharedMemorySize, LDS_BYTES);
        hipOccupancyMaxActiveBlocksPerMultiprocessor(&per_cu, (const void*)hymba_fwd, 512, LDS_BYTES);
        if (per_cu < 1) { fprintf(stderr, "occupancy query reports %d blocks per CU\n", per_cu); per_cu = 1; }
        (void)hipGetLastError();
        grid = cus;
        if (ws_size < WS_END) fprintf(stderr, "workspace too small: %zu < %zu\n", ws_size, (size_t)WS_END);
    }
    Params p{};
    for (int i = 0; i < 19; ++i) p.in[i] = (const float*)d_in[i];
    p.out = (float*)d_out; p.ws = (unsigned char*)d_ws;
    if (hipMemsetAsync((unsigned char*)d_ws + WS_BAR, 0, WS_BAR_BYTES, stream) != hipSuccess) fprintf(stderr, "hipMemsetAsync of the barrier words failed\n");
    void* args[] = {&p};
    hipError_t e = hipLaunchCooperativeKernel((const void*)hymba_fwd, dim3(grid), dim3(512), args, LDS_BYTES, stream);
    if (e != hipSuccess) fprintf(stderr, "cooperative launch failed: %s (grid %d)\n", hipGetErrorString(e), grid);
}
```

```cpp
#include <hip/hip_runtime.h>
#include <hip/hip_cooperative_groups.h>
#include <cstdio>
#include <cstdint>
namespace cg = cooperative_groups;

#define LAS __attribute__((address_space(3)))
typedef unsigned short bf16_t;
typedef short bf16x8 __attribute__((ext_vector_type(8)));
typedef short s16x4 __attribute__((ext_vector_type(4)));
typedef float f32x4 __attribute__((ext_vector_type(4)));
typedef float f32x2 __attribute__((ext_vector_type(2)));
typedef unsigned u32x4 __attribute__((ext_vector_type(4)));
typedef unsigned u32x2 __attribute__((ext_vector_type(2)));

constexpr int DM = 1024, NBATCH = 32, SEQ = 2048, DBATCH = 8, DSEQ = 32, NMETA = 16, PAST = 1024;
constexpr int ROW_S = NBATCH * SEQ;
constexpr int ROW_M = ROW_S + DBATCH * DSEQ;
constexpr int ROW_END = ROW_M + NMETA;
constexpr int RTOT = 258 * 256;
constexpr int MROWS = 257 * 256;
constexpr int NIN = 2816, DFF = 2816, NFF2 = 5632;
constexpr int NPOS = 2064;
constexpr float EPS = 1e-6f;
constexpr float LOG2E = 1.4426950408889634f, QSCALE = 0.125f * LOG2E;
constexpr size_t OFF_Y = 0, OFF_PMK = 67371008, OFF_PMV = 67436544, OFF_PWK = 67502080, OFF_PWV = 68026368, OFF_PST = 68550656,
                 OFF_SNK = 70647808, OFF_SNV = 70680576, OFF_SST = 70713344;
constexpr size_t al256(size_t x) { return (x + 255) & ~(size_t)255; }
constexpr size_t WS_CTL = 0;
constexpr size_t WS_LB = 4096;
constexpr size_t WS_ROPE = WS_LB + 2048;
constexpr size_t WS_SS1 = al256(WS_ROPE + (size_t)NPOS * 32 * 8);
constexpr size_t WS_SS2 = al256(WS_SS1 + (size_t)RTOT * 4);
constexpr size_t WS_GINV = al256(WS_SS2 + (size_t)RTOT * 4);
constexpr size_t WS_BAR = al256(WS_GINV + (size_t)DM * 4);
constexpr size_t WS_BAR_BYTES = 16384;
constexpr size_t WS_WIN = al256(WS_BAR + WS_BAR_BYTES);
constexpr size_t WS_WOUT = WS_WIN + (size_t)NIN * DM * 2;
constexpr size_t WS_WFI = WS_WOUT + (size_t)DM * DM * 2;
constexpr size_t WS_WFO = WS_WFI + (size_t)NFF2 * DM * 2;
constexpr size_t WS_XN = WS_WFO + (size_t)DM * DFF * 2;
constexpr size_t WS_BIG = WS_XN + (size_t)RTOT * DM * 2;
constexpr size_t WS_QH = WS_BIG;
constexpr size_t WS_LF = WS_QH + (size_t)RTOT * 512 * 2;
constexpr size_t WS_VH = WS_LF + (size_t)RTOT * 512 * 4;
constexpr size_t WS_GH = WS_VH + (size_t)RTOT * 512 * 2;
constexpr size_t WS_AQ = WS_GH + (size_t)RTOT * 512 * 2;
constexpr size_t WS_BIG_END = WS_AQ + (size_t)RTOT * 512 * 2;
constexpr size_t WS_ACT = WS_BIG;
static_assert(WS_ACT + (size_t)RTOT * DFF * 2 <= WS_BIG_END, "ACT overlay");
constexpr size_t WS_AK = WS_BIG_END;
constexpr size_t WS_AV = WS_AK + (size_t)RTOT * 128 * 2;
constexpr size_t WS_MIX = WS_AV + (size_t)RTOT * 128 * 2;
constexpr size_t WS_END = WS_MIX + (size_t)RTOT * DM * 2;
static_assert(WS_END <= (size_t)1 << 30, "workspace");

constexpr int LDS_BYTES = 147456;
#define REP_P1 1
#define REP_P2 1
#define REP_P4 1

struct Params { const float* in[19]; float* out; unsigned char* ws; };

__device__ __forceinline__ unsigned cvt_pk_bf16(float lo, float hi) { unsigned r; asm volatile("v_cvt_pk_bf16_f32 %0, %1, %2" : "=v"(r) : "v"(lo), "v"(hi)); return r; }
typedef _Float16 f16x2 __attribute__((ext_vector_type(2)));
__device__ __forceinline__ unsigned pk_f16(float a, float b) { f16x2 h; h.x = (_Float16)a; h.y = (_Float16)b; return __builtin_bit_cast(unsigned, h); }
__device__ __forceinline__ float bf2f(unsigned short b) { return __builtin_bit_cast(float, (unsigned)b << 16); }
__device__ __forceinline__ float bflo(unsigned u) { return __builtin_bit_cast(float, u << 16); }
__device__ __forceinline__ float bfhi(unsigned u) { return __builtin_bit_cast(float, u & 0xffff0000u); }
__device__ __forceinline__ float sigmoidf_(float v) { return __builtin_amdgcn_rcpf(1.0f + __expf(-v)); }
__device__ __forceinline__ float siluf_(float v) { return v * sigmoidf_(v); }
__device__ __forceinline__ float wave_sum(float v) {
#pragma unroll
    for (int o = 1; o < 64; o <<= 1) v += __shfl_xor(v, o);
    return v;
}
#define LDS_WAIT() asm volatile("s_waitcnt lgkmcnt(0)" ::: "memory")

namespace pg8 {
constexpr int BM = 256, BK = 64, HALF = 128, HTB = HALF * BK * 2, NXCD = 8, WGM = 8;
__host__ __device__ __forceinline__ int lds_byte(int r, int c) { const int st = (r >> 4) * 2 + (c >> 5), rr = r & 15, cc = c & 31, ob = rr * 64 + cc * 2; return st * 1024 + (ob ^ (((ob >> 9) & 1) << 5)); }
__host__ __device__ __forceinline__ void stage_rc(int b, int& R, int& C) { const int st = b / 1024, sb = b % 1024, swz = sb ^ (((sb >> 9) & 1) << 5); R = (st >> 1) * 16 + swz / 64; C = (st & 1) * 32 + (swz % 64) / 2; }
__host__ __device__ __forceinline__ int perm32(int rho) { const int n = rho >> 4, i = rho & 15; return 8 * (i >> 2) + 4 * n + (i & 3); }

struct Unit { int pm, pn, ko, nt; };
struct Gemm { const bf16_t* A; const bf16_t* Bt; int M, N, K; };

struct StaticOrder {
    int nM, nN, nwg, G, c, ntk;
    __device__ void init(int M, int N, int K, int G_, int c_) { nM = M / BM; nN = N / BM; nwg = nM * nN; G = G_; c = c_; ntk = K / BK; }
    __device__ bool next(int i, Unit& u) const {
        const long L = (long)i * G + c; if (L >= nwg) return false;
        int wgid = (int)L; { const int q = nwg / NXCD, r = nwg % NXCD, xcd = wgid % NXCD, off = wgid / NXCD; wgid = (xcd < r ? xcd * (q + 1) : r * (q + 1) + (xcd - r) * q) + off; }
        const int nig = WGM * nN, gid = wgid / nig, fm = gid * WGM, gsz = (nM - fm) < WGM ? (nM - fm) : WGM;
        u.pm = fm + ((wgid % nig) % gsz); u.pn = (wgid % nig) / gsz; u.ko = 0; u.nt = ntk; return true;
    }
};
struct DownOrder {
    StaticOrder P; int G, c;
    __device__ void init(int G_, int c_) { P.init(256 * 256, DM, DFF, G_, c_); G = G_; c = c_; }
    __device__ bool next(int i, Unit& u) const {
        const long L = (long)i * G + c; if (L < P.nwg) return P.next(i, u);
        const int x = (int)(L - P.nwg); if (x >= 44) return false;
        u.pm = 256; u.pn = x & 3; u.ko = (x >> 2) * 256; u.nt = 4; return true;
    }
};

template <class Epi, class Sched>
__device__ __forceinline__ void gemm_phase(LAS unsigned char* lds, const Gemm g, const Sched& S, const Epi& E) {
    int tid = threadIdx.x; asm volatile("" : "+v"(tid));
    const int wid = __builtin_amdgcn_readfirstlane(tid >> 6), lane = tid & 63, wr = wid >> 2, wc = wid & 3, fr = lane & 15, fq = lane >> 4;
    const int K = g.K;
    unsigned voffA[2], voffB[2];
#pragma unroll
    for (int i = 0; i < 2; ++i) { int R, C; stage_rc(tid * 16 + i * 8192, R, C); const int Rb = (R & ~31) + perm32(R & 31);
        voffA[i] = (unsigned)(R * K + C) * 2u; voffB[i] = (unsigned)(Rb * K + C) * 2u; }
    const size_t kstep = (size_t)(BK * 2);
    const size_t hstep = (size_t)HALF * K * 2;
    const size_t tstep = 2 * hstep;
    const unsigned ldsw = (unsigned)wid * 1024u;
    const int aoff = lds_byte(wr * 64 + fr, fq * 8), boff = lds_byte(wc * 32 + fr, fq * 8);
#define PG8_SA(b, h) (((b) * 2 + (h)) * HTB)
#define PG8_SB(b, h) ((4 + (b) * 2 + (h)) * HTB)
#define PG8_STAGE(bufoff, gbase, voff) do { _Pragma("unroll") for (int _i = 0; _i < 2; ++_i) \
        __builtin_amdgcn_global_load_lds((const unsigned*)((const char*)(gbase) + (voff)[_i]), (LAS unsigned*)(lds + (bufoff) + ldsw + _i * 8192), 16, 0, 0); } while (0)
#define PG8_LDA(dst, b, h) do { _Pragma("unroll") for (int m = 0; m < 4; ++m) _Pragma("unroll") for (int k = 0; k < 2; ++k) dst[m][k] = *(const LAS bf16x8*)(lds + PG8_SA(b, h) + aoff + m * 2048 + k * 1024); } while (0)
#define PG8_LDB(dst, b, h) do { _Pragma("unroll") for (int n = 0; n < 2; ++n) _Pragma("unroll") for (int k = 0; k < 2; ++k) dst[n][k] = *(const LAS bf16x8*)(lds + PG8_SB(b, h) + boff + n * 2048 + k * 1024); } while (0)
#define PG8_MMA(ai, bj, At, Bt) do { __builtin_amdgcn_s_setprio(1); _Pragma("unroll") for (int m = 0; m < 4; ++m) _Pragma("unroll") for (int n = 0; n < 2; ++n) _Pragma("unroll") for (int k = 0; k < 2; ++k) \
        acc[ai][bj][m][n] = __builtin_amdgcn_mfma_f32_16x16x32_bf16(Bt[n][k], At[m][k], acc[ai][bj][m][n], 0, 0, 0); __builtin_amdgcn_s_setprio(0); } while (0)
#define PG8_WAIT_V(n) asm volatile("s_waitcnt vmcnt(" #n ")" ::: "memory")
#define PG8_WAIT_L(n) asm volatile("s_waitcnt lgkmcnt(" #n ")" ::: "memory")
#define PG8_BAR __builtin_amdgcn_s_barrier()
#define PG8_SCHED __builtin_amdgcn_sched_barrier(0)
    Unit cur, nxt; int ui = 0;
    if (!S.next(0, cur)) return;
    f32x4 acc[2][2][4][2];
#pragma unroll
    for (int a = 0; a < 2; ++a)
#pragma unroll
        for (int b = 0; b < 2; ++b)
#pragma unroll
            for (int m = 0; m < 4; ++m)
#pragma unroll
                for (int n = 0; n < 2; ++n) acc[a][b][m][n] = (f32x4){0.f, 0.f, 0.f, 0.f};
    bf16x8 At[4][2], B0[2][2], B1[2][2];
    const char* cA = (const char*)g.A + (size_t)cur.pm * tstep + (size_t)cur.ko * 2; const char* cB = (const char*)g.Bt + (size_t)cur.pn * tstep + (size_t)cur.ko * 2;
    PG8_STAGE(PG8_SB(0, 0), cB, voffB); PG8_STAGE(PG8_SB(0, 1), cB + hstep, voffB); PG8_STAGE(PG8_SA(0, 0), cA, voffA); PG8_STAGE(PG8_SA(0, 1), cA + hstep, voffA);
    if (wr == 1) PG8_BAR;
    PG8_WAIT_V(2); PG8_BAR;
    PG8_STAGE(PG8_SB(1, 0), cB + kstep, voffB); PG8_STAGE(PG8_SA(1, 0), cA + kstep, voffA); PG8_STAGE(PG8_SB(1, 1), cB + hstep + kstep, voffB);
    PG8_WAIT_V(6); PG8_BAR;
    for (;;) {
        const bool has_next = S.next(ui + 1, nxt);
        const char* nA = has_next ? (const char*)g.A + (size_t)nxt.pm * tstep + (size_t)nxt.ko * 2 : cA; const char* nB = has_next ? (const char*)g.Bt + (size_t)nxt.pn * tstep + (size_t)nxt.ko * 2 : cB;
        const int nt = cur.nt;
        for (int t = 0; t < nt; t += 2) {
            const bool last = (t == nt - 2);
            const char* a1 = cA + (size_t)(t + 1) * kstep;
            const char* a2 = last ? nA : cA + (size_t)(t + 2) * kstep; const char* b2 = last ? nB : cB + (size_t)(t + 2) * kstep;
            const char* a3 = a2 + kstep; const char* b3 = b2 + kstep;
            PG8_LDB(B0, 0, 0); PG8_LDB(B1, 0, 1); PG8_SCHED; PG8_LDA(At, 0, 0); PG8_STAGE(PG8_SA(1, 1), a1 + hstep, voffA);
            PG8_WAIT_V(8); PG8_WAIT_L(0); PG8_BAR; PG8_MMA(0, 0, At, B0); PG8_MMA(0, 1, At, B1); PG8_BAR; PG8_SCHED;
            PG8_LDA(At, 0, 1); PG8_STAGE(PG8_SB(0, 0), b2, voffB); PG8_STAGE(PG8_SB(0, 1), b2 + hstep, voffB); PG8_STAGE(PG8_SA(0, 0), a2, voffA);
            PG8_WAIT_V(8); PG8_WAIT_L(0); PG8_BAR; PG8_MMA(1, 0, At, B0); PG8_MMA(1, 1, At, B1); PG8_BAR; PG8_SCHED;
            PG8_LDB(B0, 1, 0); PG8_LDB(B1, 1, 1); PG8_SCHED; PG8_LDA(At, 1, 0); PG8_STAGE(PG8_SA(0, 1), a2 + hstep, voffA);
            PG8_WAIT_V(8); PG8_WAIT_L(0); PG8_BAR; PG8_MMA(0, 0, At, B0); PG8_MMA(0, 1, At, B1); PG8_BAR; PG8_SCHED;
            PG8_LDA(At, 1, 1); PG8_STAGE(PG8_SB(1, 0), b3, voffB); PG8_STAGE(PG8_SB(1, 1), b3 + hstep, voffB); PG8_STAGE(PG8_SA(1, 0), a3, voffA);
            PG8_WAIT_V(8); PG8_WAIT_L(0); PG8_BAR; PG8_MMA(1, 0, At, B0); PG8_MMA(1, 1, At, B1); PG8_BAR; PG8_SCHED;
        }
        if (wr == 0) PG8_BAR;
        E(acc, cur, wr, wc, fr, fq);
        if (!has_next) break;
#pragma unroll
        for (int a = 0; a < 2; ++a)
#pragma unroll
            for (int b = 0; b < 2; ++b)
#pragma unroll
                for (int m = 0; m < 4; ++m)
#pragma unroll
                    for (int n = 0; n < 2; ++n) acc[a][b][m][n] = (f32x4){0.f, 0.f, 0.f, 0.f};
        cur = nxt; cA = nA; cB = nB; ++ui;
        if (wr == 1) PG8_BAR;
    }
    PG8_WAIT_V(0);
    PG8_BAR;
#undef PG8_SA
#undef PG8_SB
#undef PG8_STAGE
#undef PG8_LDA
#undef PG8_LDB
#undef PG8_MMA
#undef PG8_WAIT_V
#undef PG8_WAIT_L
#undef PG8_BAR
#undef PG8_SCHED
}
}

__device__ __forceinline__ u32x4 pack8(const f32x4& a, const f32x4& b) {
    u32x4 w; w.x = cvt_pk_bf16(a[0], a[1]); w.y = cvt_pk_bf16(a[2], a[3]); w.z = cvt_pk_bf16(b[0], b[1]); w.w = cvt_pk_bf16(b[2], b[3]); return w;
}
__device__ __forceinline__ u32x2 pack4(const f32x4& a) { u32x2 w; w.x = cvt_pk_bf16(a[0], a[1]); w.y = cvt_pk_bf16(a[2], a[3]); return w; }

__device__ __forceinline__ int row_pos(int row) {
    int pos;
    if (row < ROW_S) pos = NMETA + (row & (SEQ - 1));
    else if (row < ROW_M) pos = NMETA + PAST + ((row - ROW_S) & (DSEQ - 1));
    else pos = row - ROW_M;
    return pos < NPOS ? pos : NPOS - 1;
}
__device__ __forceinline__ void kv_out(float* out, size_t off_pw, size_t off_sn, size_t off_pm, int row, int c, const f32x4& v) {
    if (row < ROW_S) { const int s = row & (SEQ - 1); if (s >= SEQ - 128) { const int b = row >> 11; *(f32x4*)(out + off_pw + ((size_t)(b * 128 + s - (SEQ - 128))) * 128 + c) = v; } }
    else if (row < ROW_M) { *(f32x4*)(out + off_sn + (size_t)(row - ROW_S) * 128 + c) = v; }
    else if (row < ROW_END) { const int m = row - ROW_M;
        for (int b = 0; b < NBATCH; ++b) *(f32x4*)(out + off_pm + (size_t)(b * NMETA + m) * 128 + c) = v; }
}

struct EpiIn {
    unsigned char* ws; float* out;
    __device__ __forceinline__ void rope4(const f32x4& x1, const f32x4& x2, const f32x4& cs0, const f32x4& cs1, f32x4& o1, f32x4& o2) const {
        o1[0] = x1[0] * cs0[0] - x2[0] * cs0[1]; o2[0] = x2[0] * cs0[0] + x1[0] * cs0[1];
        o1[1] = x1[1] * cs0[2] - x2[1] * cs0[3]; o2[1] = x2[1] * cs0[2] + x1[1] * cs0[3];
        o1[2] = x1[2] * cs1[0] - x2[2] * cs1[1]; o2[2] = x2[2] * cs1[0] + x1[2] * cs1[1];
        o1[3] = x1[3] * cs1[2] - x2[3] * cs1[3]; o2[3] = x2[3] * cs1[2] + x1[3] * cs1[3];
    }
    __device__ __forceinline__ void operator()(const f32x4 (&acc)[2][2][4][2], const pg8::Unit& u, int wr, int wc, int fr, int fq) const {
        const int pn = u.pn, row0 = u.pm * 256 + wr * 64 + fr;
        if (pn < 2 || (pn >= 4 && pn < 8)) {
            bf16_t* dst = (bf16_t*)(ws + (pn < 2 ? WS_QH : (pn < 6 ? WS_VH : WS_GH))); const bool act = (pn < 2) || (pn >= 6);
            const int c0 = (pn & 1) * 256 + wc * 32 + fq * 8;
#pragma unroll
            for (int ai = 0; ai < 2; ++ai)
#pragma unroll
                for (int m = 0; m < 4; ++m) { const int row = row0 + ai * 128 + m * 16;
#pragma unroll
                    for (int bj = 0; bj < 2; ++bj) { f32x4 v0 = acc[ai][bj][m][0], v1 = acc[ai][bj][m][1];
                        if (act) {
#pragma unroll
                            for (int i = 0; i < 4; ++i) { v0[i] = siluf_(v0[i]); v1[i] = siluf_(v1[i]); } }
                        *(u32x4*)(dst + (size_t)row * 512 + c0 + bj * 128) = pack8(v0, v1); } }
        } else if (pn < 4) {
            const int c0 = (pn & 1) * 256 + wc * 32 + fq * 8;
            f32x4 lbv[2][2]; const float* lb = (const float*)(ws + WS_LB); bf16_t* LF = (bf16_t*)(ws + WS_LF);
#pragma unroll
            for (int bj = 0; bj < 2; ++bj) { lbv[bj][0] = *(const f32x4*)(lb + c0 + bj * 128); lbv[bj][1] = *(const f32x4*)(lb + c0 + bj * 128 + 4); }
#pragma unroll
            for (int ai = 0; ai < 2; ++ai)
#pragma unroll
                for (int m = 0; m < 4; ++m) { const int row = row0 + ai * 128 + m * 16;
#pragma unroll
                    for (int bj = 0; bj < 2; ++bj) { f32x4 o[2];
#pragma unroll
                        for (int n = 0; n < 2; ++n) { const f32x4 v = acc[ai][bj][m][n];
#pragma unroll
                            for (int i = 0; i < 4; ++i) { const float l = lbv[bj][n][i]; o[n][i] = __log2f(l + (1.0f - l) * sigmoidf_(v[i]));     } }
                        *(u32x4*)(LF + (size_t)row * 512 + c0 + bj * 128) = (u32x4){pk_f16(o[0][0], o[0][1]), pk_f16(o[0][2], o[0][3]), pk_f16(o[1][0], o[1][1]), pk_f16(o[1][2], o[1][3])}; } }
        } else if (pn < 10) {
            const int d_lo = (wc & 1) * 16 + fq * 4;
            const int d_w = (wc & 1) * 16 + ((fq & 1) ? 32 + (fq - 1) * 4 : fq * 4);
#pragma unroll
            for (int ai = 0; ai < 2; ++ai) {
                f32x4 cs[4][2];
#pragma unroll
                for (int m = 0; m < 4; ++m) { const float* rp = (const float*)(ws + WS_ROPE) + ((size_t)row_pos(row0 + ai * 128 + m * 16) * 32 + d_lo) * 2; cs[m][0] = *(const f32x4*)rp; cs[m][1] = *(const f32x4*)(rp + 4); }
#pragma unroll
                for (int m = 0; m < 4; ++m) { const int row = row0 + ai * 128 + m * 16;
#pragma unroll
                    for (int bj = 0; bj < 2; ++bj) { f32x4 o1, o2; rope4(acc[ai][bj][m][0], acc[ai][bj][m][1], cs[m][0], cs[m][1], o1, o2); o1 = o1 * QSCALE; o2 = o2 * QSCALE;
                        const u32x2 p1 = pack4(o1), p2 = pack4(o2);
                        const auto sx = __builtin_amdgcn_permlane16_swap(p1.x, p2.x, false, false), sy = __builtin_amdgcn_permlane16_swap(p1.y, p2.y, false, false);
                        bf16_t* p = (bf16_t*)(ws + WS_AQ) + (size_t)row * 512 + (pn - 8) * 256 + (bj * 2 + (wc >> 1)) * 64 + d_w;
                        *(u32x4*)p = (u32x4){sx[0], sy[0], sx[1], sy[1]}; } } }
        } else {
            const int d_lo = (wc & 1) * 16 + fq * 4, g = wc >> 1;
#pragma unroll
            for (int ai = 0; ai < 2; ++ai) {
                f32x4 cs[4][2];
#pragma unroll
                for (int m = 0; m < 4; ++m) { const float* rp = (const float*)(ws + WS_ROPE) + ((size_t)row_pos(row0 + ai * 128 + m * 16) * 32 + d_lo) * 2; cs[m][0] = *(const f32x4*)rp; cs[m][1] = *(const f32x4*)(rp + 4); }
#pragma unroll
                for (int m = 0; m < 4; ++m) { const int row = row0 + ai * 128 + m * 16;
                    f32x4 o1, o2; rope4(acc[ai][0][m][0], acc[ai][0][m][1], cs[m][0], cs[m][1], o1, o2);
                    bf16_t* p = (bf16_t*)(ws + WS_AK) + (size_t)row * 128 + g * 64 + d_lo;
                    *(u32x2*)p = pack4(o1); *(u32x2*)(p + 32) = pack4(o2);
                    const int c = wc * 32 + fq * 8;
                    *(u32x4*)((bf16_t*)(ws + WS_AV) + (size_t)row * 128 + c) = pack8(acc[ai][1][m][0], acc[ai][1][m][1]);
} }
        }
    }
};

struct EpiOut {
    bf16_t* HB; float* SS; const float* irs; const float* ginv;
    __device__ __forceinline__ void operator()(const f32x4 (&acc)[2][2][4][2], const pg8::Unit& u, int wr, int wc, int fr, int fq) const {
        const int row0 = u.pm * 256 + wr * 64 + fr, c0 = u.pn * 256 + wc * 32 + fq * 8;
        float irv[8];
#pragma unroll
        for (int i = 0; i < 8; ++i) irv[i] = irs[row0 + (i >> 2) * 128 + (i & 3) * 16];
        f32x4 gi[2][2];
#pragma unroll
        for (int bj = 0; bj < 2; ++bj) { gi[bj][0] = *(const f32x4*)(ginv + c0 + bj * 128); gi[bj][1] = *(const f32x4*)(ginv + c0 + bj * 128 + 4); }
#pragma unroll
        for (int ai = 0; ai < 2; ++ai) {
            u32x4 xbv[2][4][2];
#pragma unroll
            for (int m = 0; m < 4; ++m)
#pragma unroll
                for (int bj = 0; bj < 2; ++bj) xbv[ai][m][bj] = *(const u32x4*)(HB + (size_t)(row0 + ai * 128 + m * 16) * DM + c0 + bj * 128);
#pragma unroll
            for (int m = 0; m < 4; ++m) { const int row = row0 + ai * 128 + m * 16; const float ir = irv[ai * 4 + m]; float ss = 0.f;
#pragma unroll
                for (int bj = 0; bj < 2; ++bj) { bf16_t* hp = HB + (size_t)row * DM + c0 + bj * 128;
                    const u32x4 xb = xbv[ai][m][bj];
                    const f32x4 x0 = (f32x4){bflo(xb.x), bfhi(xb.x), bflo(xb.y), bfhi(xb.y)} * gi[bj][0] * ir, x1 = (f32x4){bflo(xb.z), bfhi(xb.z), bflo(xb.w), bfhi(xb.w)} * gi[bj][1] * ir;
                    const f32x4 h0 = acc[ai][bj][m][0] + x0, h1 = acc[ai][bj][m][1] + x1;
                    *(u32x4*)hp = pack8(h0, h1);
                    ss += (h0[0] * h0[0] + h0[1] * h0[1]) + (h0[2] * h0[2] + h0[3] * h0[3]) + (h1[0] * h1[0] + h1[1] * h1[1]) + (h1[2] * h1[2] + h1[3] * h1[3]); }
                ss += __shfl_xor(ss, 16); ss += __shfl_xor(ss, 32);
                if (fq == 0) atomicAdd(SS + row, ss); }
        }
    }
};

struct EpiSwi {
    bf16_t* ACT; float* SS;
    __device__ __forceinline__ void operator()(const f32x4 (&acc)[2][2][4][2], const pg8::Unit& u, int wr, int wc, int fr, int fq) const {
        const int row0 = u.pm * 256 + wr * 64 + fr;
        const int cw = u.pn * 128 + wc * 16 + ((fq & 1) ? 64 + (fq - 1) * 4 : fq * 4);
        float ssv[8];
#pragma unroll
        for (int i = 0; i < 8; ++i) ssv[i] = __hip_atomic_load(SS + row0 + (i >> 2) * 128 + (i & 3) * 16, __ATOMIC_RELAXED, __HIP_MEMORY_SCOPE_AGENT);
#pragma unroll
        for (int ai = 0; ai < 2; ++ai)
#pragma unroll
            for (int m = 0; m < 4; ++m) { const int row = row0 + ai * 128 + m * 16;
                const float rs = rsqrtf(ssv[ai * 4 + m] * (1.0f / DM) + EPS);
                u32x2 pk[2];
#pragma unroll
                for (int bj = 0; bj < 2; ++bj) { f32x4 a;
#pragma unroll
                    for (int i = 0; i < 4; ++i) { const float gt = acc[ai][bj][m][0][i] * rs, up = acc[ai][bj][m][1][i] * rs; a[i] = siluf_(gt) * up; }
                    pk[bj] = pack4(a); }
                const auto sx = __builtin_amdgcn_permlane16_swap(pk[0].x, pk[1].x, false, false), sy = __builtin_amdgcn_permlane16_swap(pk[0].y, pk[1].y, false, false);
                *(u32x4*)(ACT + (size_t)row * DFF + cw) = (u32x4){sx[0], sy[0], sx[1], sy[1]}; }
    }
};

__device__ __forceinline__ void st_wt8(float* p, float a, float b) {
    const unsigned long long v = (unsigned long long)__builtin_bit_cast(unsigned, a) | ((unsigned long long)__builtin_bit_cast(unsigned, b) << 32);
    __hip_atomic_store((unsigned long long*)p, v, __ATOMIC_RELAXED, __HIP_MEMORY_SCOPE_AGENT);
}
template <int NR>
__device__ __forceinline__ void norm_rows(float* y0, const f32x4 (&gv)[4], int lane) {
    f32x4 a[NR][4]; float sq[NR];
#pragma unroll
    for (int r = 0; r < NR; ++r)
#pragma unroll
        for (int j = 0; j < 4; ++j) a[r][j] = *(const f32x4*)(y0 + (size_t)r * DM + 4 * lane + 256 * j);
#pragma unroll
    for (int r = 0; r < NR; ++r) { float q = 0.f;
#pragma unroll
        for (int j = 0; j < 4; ++j) q += (a[r][j][0] * a[r][j][0] + a[r][j][1] * a[r][j][1]) + (a[r][j][2] * a[r][j][2] + a[r][j][3] * a[r][j][3]);
        sq[r] = rsqrtf(wave_sum(q) * (1.0f / DM) + EPS); }
#pragma unroll
    for (int r = 0; r < NR; ++r)
#pragma unroll
        for (int j = 0; j < 4; ++j) *(f32x4*)(y0 + (size_t)r * DM + 4 * lane + 256 * j) = a[r][j] * sq[r] * gv[j];
}
struct EpiDown {
    float* Y; const bf16_t* HB; unsigned* cnt; const float* fnorm; float* xbuf; LAS float* scr; int fused;
    __device__ __forceinline__ void operator()(const f32x4 (&acc)[2][2][4][2], const pg8::Unit& u, int wr, int wc, int fr, int fq) const {
        const int row0 = u.pm * 256 + wr * 64 + fr, c0 = u.pn * 256 + wc * 32 + fq * 8;
        if (u.pm >= 256) {
#pragma unroll
            for (int ai = 0; ai < 2; ++ai)
#pragma unroll
                for (int m = 0; m < 4; ++m) { const int row = row0 + ai * 128 + m * 16;
#pragma unroll
                    for (int bj = 0; bj < 2; ++bj) { float* yp = Y + (size_t)row * DM + c0 + bj * 128;
#pragma unroll
                        for (int i = 0; i < 4; ++i) { atomicAdd(yp + i, acc[ai][bj][m][0][i]); atomicAdd(yp + 4 + i, acc[ai][bj][m][1][i]); } } }
            return;
        }
        if (!fused) {
#pragma unroll
            for (int ai = 0; ai < 2; ++ai) {
                u32x4 hbv[4][2];
#pragma unroll
                for (int m = 0; m < 4; ++m)
#pragma unroll
                    for (int bj = 0; bj < 2; ++bj) hbv[m][bj] = *(const u32x4*)(HB + (size_t)(row0 + ai * 128 + m * 16) * DM + c0 + bj * 128);
#pragma unroll
                for (int m = 0; m < 4; ++m) { const int row = row0 + ai * 128 + m * 16;
#pragma unroll
                    for (int bj = 0; bj < 2; ++bj) { const u32x4 hb = hbv[m][bj];
                        const f32x4 h0 = acc[ai][bj][m][0] + (f32x4){bflo(hb.x), bfhi(hb.x), bflo(hb.y), bfhi(hb.y)}, h1 = acc[ai][bj][m][1] + (f32x4){bflo(hb.z), bfhi(hb.z), bflo(hb.w), bfhi(hb.w)};
                        *(u32x4*)((bf16_t*)HB + (size_t)row * DM + c0 + bj * 128) = pack8(h0, h1); } }
            }
            return;
        }
#pragma unroll
        for (int ai = 0; ai < 2; ++ai) {
            u32x4 hbv[4][2];
#pragma unroll
            for (int m = 0; m < 4; ++m)
#pragma unroll
                for (int bj = 0; bj < 2; ++bj) hbv[m][bj] = *(const u32x4*)((const char*)HB + ((unsigned)(row0 + ai * 128 + m * 16) * (unsigned)(DM * 2) + (unsigned)(c0 + bj * 128) * 2u));
#pragma unroll
            for (int m = 0; m < 4; ++m) { float q = 0.f;
#pragma unroll
                for (int bj = 0; bj < 2; ++bj) { const u32x4 hb = hbv[m][bj];
                    const f32x4 h0 = acc[ai][bj][m][0] + (f32x4){bflo(hb.x), bfhi(hb.x), bflo(hb.y), bfhi(hb.y)}, h1 = acc[ai][bj][m][1] + (f32x4){bflo(hb.z), bfhi(hb.z), bflo(hb.w), bfhi(hb.w)};
                    q += (h0[0] * h0[0] + h0[1] * h0[1]) + (h0[2] * h0[2] + h0[3] * h0[3]) + (h1[0] * h1[0] + h1[1] * h1[1]) + (h1[2] * h1[2] + h1[3] * h1[3]); }
                q += __shfl_xor(q, 16); q += __shfl_xor(q, 32);
                if (fq == 0) scr[(ai * 128 + wr * 64 + m * 16 + fr) * 4 + wc] = q; }
        }
        asm volatile("s_waitcnt lgkmcnt(0)" ::: "memory");
        __builtin_amdgcn_s_barrier();
        if (threadIdx.x < 256) { const f32x4 p4 = *(const LAS f32x4*)(scr + threadIdx.x * 4);
            __hip_atomic_store(xbuf + ((size_t)u.pm * 256 + threadIdx.x) * 4 + u.pn, (p4[0] + p4[1]) + (p4[2] + p4[3]), __ATOMIC_RELAXED, __HIP_MEMORY_SCOPE_AGENT); }
        asm volatile("s_waitcnt vmcnt(0)" ::: "memory");
        __builtin_amdgcn_s_barrier();
        if (threadIdx.x == 0) {
            __hip_atomic_fetch_add(cnt + u.pm, 1u, __ATOMIC_RELAXED, __HIP_MEMORY_SCOPE_AGENT);
            unsigned spins = 0;
            while (__hip_atomic_load(cnt + u.pm, __ATOMIC_RELAXED, __HIP_MEMORY_SCOPE_AGENT) < 4u && ++spins < (1u << 22)) __builtin_amdgcn_s_sleep(1);
        }
        __builtin_amdgcn_s_barrier();
        if (threadIdx.x < 256) {
            const float* xp = xbuf + ((size_t)u.pm * 256 + threadIdx.x) * 4;
            const float t0 = __hip_atomic_load(xp, __ATOMIC_RELAXED, __HIP_MEMORY_SCOPE_AGENT), t1 = __hip_atomic_load(xp + 1, __ATOMIC_RELAXED, __HIP_MEMORY_SCOPE_AGENT),
                        t2 = __hip_atomic_load(xp + 2, __ATOMIC_RELAXED, __HIP_MEMORY_SCOPE_AGENT), t3 = __hip_atomic_load(xp + 3, __ATOMIC_RELAXED, __HIP_MEMORY_SCOPE_AGENT);
            scr[1024 + threadIdx.x] = rsqrtf(((t0 + t1) + (t2 + t3)) * (1.0f / DM) + EPS); }
        asm volatile("s_waitcnt lgkmcnt(0)" ::: "memory");
        __builtin_amdgcn_s_barrier();
        f32x4 gn[2][2];
#pragma unroll
        for (int bj = 0; bj < 2; ++bj) { gn[bj][0] = *(const f32x4*)(fnorm + c0 + bj * 128); gn[bj][1] = *(const f32x4*)(fnorm + c0 + bj * 128 + 4); }
#pragma unroll
        for (int ai = 0; ai < 2; ++ai) {
            u32x4 hbv[4][2];
#pragma unroll
            for (int m = 0; m < 4; ++m)
#pragma unroll
                for (int bj = 0; bj < 2; ++bj) hbv[m][bj] = *(const u32x4*)((const char*)HB + ((unsigned)(row0 + ai * 128 + m * 16) * (unsigned)(DM * 2) + (unsigned)(c0 + bj * 128) * 2u));
#pragma unroll
            for (int m = 0; m < 4; ++m) { const int row = row0 + ai * 128 + m * 16; const float r = scr[1024 + wr * 64 + fr + ai * 128 + m * 16];
#pragma unroll
                for (int bj = 0; bj < 2; ++bj) { const u32x4 hb = hbv[m][bj]; float* yp = (float*)((char*)Y + ((unsigned)row * (unsigned)(DM * 4) + (unsigned)(c0 + bj * 128) * 4u));
                    const f32x4 h0 = acc[ai][bj][m][0] + (f32x4){bflo(hb.x), bfhi(hb.x), bflo(hb.y), bfhi(hb.y)}, h1 = acc[ai][bj][m][1] + (f32x4){bflo(hb.z), bfhi(hb.z), bflo(hb.w), bfhi(hb.w)};
                    *(f32x4*)yp = h0 * r * gn[bj][0]; *(f32x4*)(yp + 4) = h1 * r * gn[bj][1]; } }
        }
    }
};

__device__ __forceinline__ int map_in(int p) {
    if (p < 2048 || p >= 2688) return p;
    const int q = p - 2048, head = q >> 6, pp = q & 63, wcp = pp >> 5, fq = (pp >> 3) & 3, n = (pp >> 2) & 1, i = pp & 3;
    return 2048 + head * 64 + n * 32 + wcp * 16 + fq * 4 + i;
}
__device__ __forceinline__ int map_ffn(int p) {
    const int G = p >> 5, fq = (p >> 3) & 3, n = (p >> 2) & 1, i = p & 3; return n * DFF + G * 16 + fq * 4 + i;
}
template <int MAP>
__device__ __forceinline__ void p0_transpose_item(const float* W, int K, int N, bf16_t* WT, const float* gain, LAS float* scr, int item, int lane) {
    const int nblk = N / 32, kb = item / nblk, nb = item % nblk, k0 = 64 * kb, n0 = 32 * nb;
    const int pc = n0 + (lane & 31); const int lc = MAP == 1 ? map_in(pc) : (MAP == 2 ? map_ffn(pc) : pc);
    float wv[32];
#pragma unroll
    for (int i = 0; i < 32; ++i) wv[i] = W[(size_t)(k0 + 2 * i + (lane >> 5)) * N + lc];
#pragma unroll
    for (int i = 0; i < 32; ++i) { const int kk = 2 * i + (lane >> 5); float w = wv[i]; if (gain) w *= gain[k0 + kk]; scr[kk * 33 + (lane & 31)] = w; }
    LDS_WAIT(); asm volatile("" ::: "memory");
    const int c = lane & 7;
#pragma unroll
    for (int j = 0; j < 4; ++j) { const int n = (lane >> 3) + 8 * j; const LAS float* s = scr + (8 * c) * 33 + n;
        u32x4 o; o.x = cvt_pk_bf16(s[0 * 33], s[1 * 33]); o.y = cvt_pk_bf16(s[2 * 33], s[3 * 33]); o.z = cvt_pk_bf16(s[4 * 33], s[5 * 33]); o.w = cvt_pk_bf16(s[6 * 33], s[7 * 33]);
        *(u32x4*)(WT + (size_t)(n0 + n) * K + k0 + 8 * c) = o; }
    LDS_WAIT(); asm volatile("" ::: "memory");
}

__device__ __forceinline__ void p0_prologue(const Params& P, LAS unsigned char* lds) {
    const int tid = threadIdx.x, lane = tid & 63, wave = tid >> 6;
    const int gw = blockIdx.x * 8 + wave, NGW = gridDim.x * 8;
    unsigned char* ws = P.ws;
    LAS float* scr = (LAS float*)(lds + wave * 16384);
    constexpr int I_IN = 16 * (NIN / 32), I_OUT = 16 * 32, I_FI = 16 * (NFF2 / 32), I_FO = (DFF / 64) * 32;
    for (int it = gw; it < I_IN + I_OUT + I_FI + I_FO; it += NGW) {
        int r = it;
        if (r < I_IN) { p0_transpose_item<1>(P.in[9], DM, NIN, (bf16_t*)(ws + WS_WIN), nullptr, scr, r, lane); continue; } r -= I_IN;
        if (r < I_OUT) { p0_transpose_item<0>(P.in[14], DM, DM, (bf16_t*)(ws + WS_WOUT), nullptr, scr, r, lane); continue; } r -= I_OUT;
        if (r < I_FI) { p0_transpose_item<2>(P.in[16], DM, NFF2, (bf16_t*)(ws + WS_WFI), P.in[15], scr, r, lane); continue; } r -= I_FI;
        p0_transpose_item<0>(P.in[17], DFF, DM, (bf16_t*)(ws + WS_WFO), nullptr, scr, r, lane);
    }
    {
        const float* g1 = P.in[8]; bf16_t* XN = (bf16_t*)(ws + WS_XN);
        f32x4 gv[4];
#pragma unroll
        for (int j = 0; j < 4; ++j) gv[j] = *(const f32x4*)(g1 + 4 * lane + 256 * j);
        for (int q4 = gw; q4 < RTOT / 4; q4 += NGW) {
            const int r0 = q4 * 4;
            if (r0 >= ROW_END) {
#pragma unroll
                for (int rr = 0; rr < 4; ++rr) { unsigned long long* o8 = (unsigned long long*)(XN + (size_t)(r0 + rr) * DM) + lane;
#pragma unroll
                    for (int j = 0; j < 4; ++j) o8[64 * j] = 0ull; }
                continue; }
            const float* src = r0 < ROW_S ? P.in[0] + (size_t)r0 * DM : (r0 < ROW_M ? P.in[1] + (size_t)(r0 - ROW_S) * DM : P.in[7] + (size_t)(r0 - ROW_M) * DM);
            f32x4 v[4][4]; float sq[4];
#pragma unroll
            for (int rr = 0; rr < 4; ++rr)
#pragma unroll
                for (int j = 0; j < 4; ++j) v[rr][j] = *(const f32x4*)(src + (size_t)rr * DM + 4 * lane + 256 * j);
#pragma unroll
            for (int rr = 0; rr < 4; ++rr) { float s_ = 0.f;
#pragma unroll
                for (int j = 0; j < 4; ++j) s_ += (v[rr][j][0] * v[rr][j][0] + v[rr][j][1] * v[rr][j][1]) + (v[rr][j][2] * v[rr][j][2] + v[rr][j][3] * v[rr][j][3]);
                const float ms_ = wave_sum(s_) * (1.0f / DM) + EPS; sq[rr] = rsqrtf(ms_); if (lane == 0) ((float*)(ws + WS_SS2))[r0 + rr] = sqrtf(ms_); }
#pragma unroll
            for (int rr = 0; rr < 4; ++rr) {
                u32x2 pc[4];
#pragma unroll
                for (int j = 0; j < 4; ++j) { const f32x4 y = v[rr][j] * sq[rr] * gv[j]; pc[j] = pack4(y); }
                bf16_t* xr = XN + (size_t)(r0 + rr) * DM;
#pragma unroll
                for (int j = 0; j < 4; j += 2) { const bool odd = lane & 1;
                    const unsigned sx = odd ? pc[j].x : pc[j + 1].x, sy = odd ? pc[j].y : pc[j + 1].y;
                    const unsigned rx = (unsigned)__shfl_xor((int)sx, 1), ry = (unsigned)__shfl_xor((int)sy, 1);
                    const u32x4 o = odd ? (u32x4){rx, ry, pc[j + 1].x, pc[j + 1].y} : (u32x4){pc[j].x, pc[j].y, rx, ry};
                    *(u32x4*)(xr + 256 * (j + (odd ? 1 : 0)) + 4 * (lane & ~1)) = o; } }
        }
    }
    {
        const int gt = blockIdx.x * 512 + tid, NGT = gridDim.x * 512;
        float* lb = (float*)(ws + WS_LB); float* rope = (float*)(ws + WS_ROPE); float* ss1 = (float*)(ws + WS_SS1);
        if (gt < 512) { const float p0 = P.in[10][gt], p1 = P.in[10][512 + gt]; lb[gt] = 1.0f / (1.0f + expf(p1 - p0)); }
        if (gt < 320) { ((unsigned*)(ws + WS_CTL))[gt] = 0u; }
        if (gt < DM) ((float*)(ws + WS_GINV))[gt] = 1.0f / P.in[8][gt];
        for (int i = gt; i < NPOS * 32; i += NGT) { const int pos = i >> 5, d = i & 31;
            const double inv = exp(-(double)d * (9.210340371976184 / 32.0)), ang = (double)pos * inv;
            rope[2 * i] = (float)cos(ang); rope[2 * i + 1] = (float)sin(ang); }
        for (int i = gt; i < RTOT; i += NGT) ss1[i] = 0.f;
    }
}

constexpr int HG_QD = 0, HG_KD = 17408, HG_QB = 34816, HG_KLT = 52224, HG_VT = 70656, HG_ST = 89088, HG_AM = 123904, HG_SEG = 133120, HG_DL = 137216, HG_RSS = 137728;
constexpr int PK = 272  , PT = 144  ;

__device__ __forceinline__ void hgrn_unit(const Params& P, LAS unsigned char* lds, int kind, int b, int h) {
    const int tid = threadIdx.x, lane = tid & 63, w = __builtin_amdgcn_readfirstlane(tid >> 6), fr = lane & 15, fq = lane >> 4;
    unsigned char* ws = P.ws;
    const bf16_t* QH = (const bf16_t*)(ws + WS_QH); const bf16_t* LF = (const bf16_t*)(ws + WS_LF); const bf16_t* VH = (const bf16_t*)(ws + WS_VH);
    const bf16_t* GH = (const bf16_t*)(ws + WS_GH); bf16_t* MIX = (bf16_t*)(ws + WS_MIX); const float* hgn = P.in[11];
    const int k = tid & 127, seg = tid >> 7;
    const int kp = w & 3, vh = w >> 2;
    f32x4 sacc[2][4];
    if (kind == 0) {
#pragma unroll
        for (int a = 0; a < 2; ++a)
#pragma unroll
            for (int c = 0; c < 4; ++c) sacc[a][c] = (f32x4){0.f, 0.f, 0.f, 0.f};
    } else {
        const float* S0 = P.in[6] + (size_t)(b * 4 + h) * 16384;
#pragma unroll
        for (int a = 0; a < 2; ++a)
#pragma unroll
            for (int c = 0; c < 4; ++c)
#pragma unroll
                for (int j = 0; j < 4; ++j) sacc[a][c][j] = S0[(size_t)((kp * 2 + a) * 16 + fq * 4 + j) * 128 + (vh * 4 + c) * 16 + fr];
    }
    f32x4 gnv[4];
#pragma unroll
    for (int c = 0; c < 4; ++c) gnv[c] = *(const f32x4*)(hgn + h * 128 + (vh * 4 + c) * 16 + fq * 4);
    const int nchunks = kind == 0 ? 33 : 1;
#define BAR_LDS() do { asm volatile("s_waitcnt lgkmcnt(0)" ::: "memory"); __builtin_amdgcn_s_barrier(); asm volatile("" ::: "memory"); } while (0)
#define HG_DESC(ci_, row0_, nvalid_, wout_) do { if (kind == 0) { if ((ci_) == 0) { row0_ = ROW_M; nvalid_ = NMETA; wout_ = false; } else { row0_ = b * SEQ + ((ci_) - 1) * 64; nvalid_ = 64; wout_ = true; } } \
        else { row0_ = ROW_S + b * DSEQ; nvalid_ = DSEQ; wout_ = true; } } while (0)
#define HG_LOAD(ci_) do { int r0_, nv_; bool wo_; HG_DESC(ci_, r0_, nv_, wo_); (void)wo_; \
        if (w * 8 < nv_) { const size_t ro_ = (size_t)(r0_ + w * 8) * 512 + h * 128; const bf16_t* lp_ = LF + ro_; const bf16_t* qp_ = QH + ro_; const bf16_t* vp_ = VH + ro_; \
            _Pragma("unroll") for (int i = 0; i < 8; ++i) { lfr[i] = *(const unsigned*)(lp_ + i * 512 + 2 * lane); qraw[i] = *(const unsigned*)(qp_ + i * 512 + 2 * lane); vraw[i] = *(const unsigned*)(vp_ + i * 512 + 2 * lane); } } \
        else { _Pragma("unroll") for (int i = 0; i < 8; ++i) { lfr[i] = 0u; qraw[i] = 0u; vraw[i] = 0u; } } } while (0)
    unsigned lfr[8], qraw[8], vraw[8];
    f32x4 oa[4]; u32x2 gg[4]; int prow0 = 0, pnvalid = 0; bool pwout = false;
#pragma unroll
    for (int c = 0; c < 4; ++c) { oa[c] = (f32x4){0.f, 0.f, 0.f, 0.f}; gg[c] = (u32x2){0u, 0u}; }
#define HG_READOUT() do { if (pwout) { const int t = (w & 3) * 16 + fr; \
            const float tot = ((LAS float*)(lds + HG_RSS))[t * 2] + ((LAS float*)(lds + HG_RSS))[t * 2 + 1]; \
            const float rs = rsqrtf(tot * (1.0f / 128.0f) + EPS); const size_t row = (size_t)(prow0 + t); \
            _Pragma("unroll") for (int c = 0; c < 4; c += 2) { u32x2 pp[2]; \
                _Pragma("unroll") for (int e = 0; e < 2; ++e) { const f32x4 gn = gnv[c + e]; f32x4 y; \
                    y[0] = oa[c + e][0] * rs * gn[0] * bflo(gg[c + e].x); y[1] = oa[c + e][1] * rs * gn[1] * bfhi(gg[c + e].x); \
                    y[2] = oa[c + e][2] * rs * gn[2] * bflo(gg[c + e].y); y[3] = oa[c + e][3] * rs * gn[3] * bfhi(gg[c + e].y); pp[e] = pack4(y); } \
                const auto sx = __builtin_amdgcn_permlane16_swap(pp[0].x, pp[1].x, false, false), sy = __builtin_amdgcn_permlane16_swap(pp[0].y, pp[1].y, false, false); \
                const int v0 = h * 128 + (vh * 4 + c + (fq & 1)) * 16 + ((fq & 1) ? (fq - 1) * 4 : fq * 4); \
                if (t < pnvalid) *(u32x4*)(MIX + row * DM + v0) = (u32x4){sx[0], sy[0], sx[1], sy[1]}; } } } while (0)
    HG_LOAD(0);
    for (int ci = 0; ci < nchunks; ++ci) {
        int row0, nvalid; bool wout; HG_DESC(ci, row0, nvalid, wout);
        f32x2 lf[8]; unsigned qr[8], vr[8];
#pragma unroll
        for (int i = 0; i < 8; ++i) { const f16x2 hh = __builtin_bit_cast(f16x2, lfr[i]); lf[i].x = (float)hh.x; lf[i].y = (float)hh.y; qr[i] = qraw[i]; vr[i] = vraw[i]; }
        if (ci + 1 < nchunks) HG_LOAD(ci + 1);
        f32x2 cs[8]; { f32x2 a = (f32x2){0.f, 0.f};
#pragma unroll
            for (int i = 0; i < 8; ++i) { a = a + lf[i]; cs[i] = a; } }
        *(LAS f32x2*)(lds + HG_SEG + (w * 128 + 2 * lane) * 4) = cs[7];
        BAR_LDS();
        f32x2 pre = (f32x2){0.f, 0.f}, bm = (f32x2){0.f, 0.f}, bL;
        { f32x2 hi = (f32x2){0.f, 0.f};
#pragma unroll
            for (int sgi = 0; sgi < 8; ++sgi) { const f32x2 sv = *(const LAS f32x2*)(lds + HG_SEG + (sgi * 128 + 2 * lane) * 4);
                if (sgi < w) pre = pre + sv;
                if (sgi < 4) bm = bm + sv; else hi = hi + sv; }
            bL = bm + hi; }
        f32x2 em, elm; em.x = __builtin_amdgcn_exp2f(bm.x); em.y = __builtin_amdgcn_exp2f(bm.y); elm.x = __builtin_amdgcn_exp2f(bL.x - bm.x); elm.y = __builtin_amdgcn_exp2f(bL.y - bm.y);
        if (w == 0) { f32x2 dl; dl.x = __builtin_amdgcn_exp2f(bL.x); dl.y = __builtin_amdgcn_exp2f(bL.y); *(LAS f32x2*)(lds + HG_DL + 2 * lane * 4) = dl; }
        f32x2 klv[8];
#pragma unroll
        for (int i = 0; i < 8; ++i) { const int t = w * 8 + i;
            const f32x2 d = (pre + cs[i]) - bm;
            f32x2 e1, r1, kk, q;
            e1.x = __builtin_amdgcn_exp2f(d.x); e1.y = __builtin_amdgcn_exp2f(d.y); r1.x = __builtin_amdgcn_exp2f(-d.x); r1.y = __builtin_amdgcn_exp2f(-d.y);
            kk.x = 1.0f - __builtin_amdgcn_exp2f(lf[i].x); kk.y = 1.0f - __builtin_amdgcn_exp2f(lf[i].y);
            q.x = bflo(qr[i]); q.y = bfhi(qr[i]);
            const f32x2 qd = q * e1, kd = kk * r1, qb = qd * em; klv[i] = kd * elm;
            *(LAS unsigned*)(lds + HG_QD + t * PK + lane * 4) = cvt_pk_bf16(qd.x, qd.y);
            *(LAS unsigned*)(lds + HG_KD + t * PK + lane * 4) = cvt_pk_bf16(kd.x, kd.y);
            *(LAS unsigned*)(lds + HG_QB + t * PK + lane * 4) = cvt_pk_bf16(qb.x, qb.y); }
        {
            u32x4 k0, k1, v0, v1;
            k0.x = cvt_pk_bf16(klv[0].x, klv[1].x); k0.y = cvt_pk_bf16(klv[2].x, klv[3].x); k0.z = cvt_pk_bf16(klv[4].x, klv[5].x); k0.w = cvt_pk_bf16(klv[6].x, klv[7].x);
            k1.x = cvt_pk_bf16(klv[0].y, klv[1].y); k1.y = cvt_pk_bf16(klv[2].y, klv[3].y); k1.z = cvt_pk_bf16(klv[4].y, klv[5].y); k1.w = cvt_pk_bf16(klv[6].y, klv[7].y);
            v0.x = __builtin_amdgcn_perm(vr[1], vr[0], 0x05040100u); v0.y = __builtin_amdgcn_perm(vr[3], vr[2], 0x05040100u); v0.z = __builtin_amdgcn_perm(vr[5], vr[4], 0x05040100u); v0.w = __builtin_amdgcn_perm(vr[7], vr[6], 0x05040100u);
            v1.x = __builtin_amdgcn_perm(vr[1], vr[0], 0x07060302u); v1.y = __builtin_amdgcn_perm(vr[3], vr[2], 0x07060302u); v1.z = __builtin_amdgcn_perm(vr[5], vr[4], 0x07060302u); v1.w = __builtin_amdgcn_perm(vr[7], vr[6], 0x07060302u);
            *(LAS u32x4*)(lds + HG_KLT + (2 * lane) * PT + w * 16) = k0; *(LAS u32x4*)(lds + HG_KLT + (2 * lane + 1) * PT + w * 16) = k1;
            *(LAS u32x4*)(lds + HG_VT + (2 * lane) * PT + w * 16) = v0; *(LAS u32x4*)(lds + HG_VT + (2 * lane + 1) * PT + w * 16) = v1;
        }
        HG_READOUT();
        prow0 = row0; pnvalid = nvalid; pwout = wout;
        { const int t = (w & 3) * 16 + fr;
#pragma unroll
            for (int c = 0; c < 4; ++c) gg[c] = *(const u32x2*)(GH + (size_t)(row0 + t) * 512 + h * 128 + (vh * 4 + c) * 16 + fq * 4); }
#pragma unroll
        for (int a = 0; a < 2; ++a)
#pragma unroll
            for (int c = 0; c < 4; ++c) { const int kk0 = (kp * 2 + a) * 16 + fq * 4, v = (vh * 4 + c) * 16 + fr;
                *(LAS u32x2*)(lds + HG_ST + v * PK + kk0 * 2) = pack4(sacc[a][c]); }
        BAR_LDS();
        {
            const int st = w & 3, tt0 = (w >> 2) * 2;
            f32x4 aa[2] = {(f32x4){0.f, 0.f, 0.f, 0.f}, (f32x4){0.f, 0.f, 0.f, 0.f}};
#pragma unroll
            for (int kk = 0; kk < 4; ++kk) { const bf16x8 af = *(const LAS bf16x8*)(lds + HG_KD + (st * 16 + fr) * PK + kk * 64 + fq * 16);
#pragma unroll
                for (int e = 0; e < 2; ++e) { const bf16x8 bfq = *(const LAS bf16x8*)(lds + HG_QD + ((tt0 + e) * 16 + fr) * PK + kk * 64 + fq * 16);
                    aa[e] = __builtin_amdgcn_mfma_f32_16x16x32_bf16(af, bfq, aa[e], 0, 0, 0); } }
#pragma unroll
            for (int e = 0; e < 2; ++e) { const int t = (tt0 + e) * 16 + fr, sb = st * 16 + fq * 4; f32x4 m;
#pragma unroll
                for (int j = 0; j < 4; ++j) m[j] = (sb + j <= t) ? aa[e][j] : 0.f;
                *(LAS u32x2*)(lds + HG_AM + t * PT + sb * 2) = pack4(m); }
        }
        BAR_LDS();
        const int tt = w & 3;
        {
#pragma unroll
            for (int c = 0; c < 4; ++c) oa[c] = (f32x4){0.f, 0.f, 0.f, 0.f};
#pragma unroll
            for (int kk = 0; kk < 4; ++kk) { const bf16x8 bq = *(const LAS bf16x8*)(lds + HG_QB + (tt * 16 + fr) * PK + kk * 64 + fq * 16);
#pragma unroll
                for (int c = 0; c < 4; ++c) { const bf16x8 af = *(const LAS bf16x8*)(lds + HG_ST + ((vh * 4 + c) * 16 + fr) * PK + kk * 64 + fq * 16);
                    oa[c] = __builtin_amdgcn_mfma_f32_16x16x32_bf16(af, bq, oa[c], 0, 0, 0); } }
#pragma unroll
            for (int ss = 0; ss < 2; ++ss) { const bf16x8 bq = *(const LAS bf16x8*)(lds + HG_AM + (tt * 16 + fr) * PT + ss * 64 + fq * 16);
#pragma unroll
                for (int c = 0; c < 4; ++c) { const bf16x8 af = *(const LAS bf16x8*)(lds + HG_VT + ((vh * 4 + c) * 16 + fr) * PT + ss * 64 + fq * 16);
                    oa[c] = __builtin_amdgcn_mfma_f32_16x16x32_bf16(af, bq, oa[c], 0, 0, 0); } }
            float q = 0.f;
#pragma unroll
            for (int c = 0; c < 4; ++c) q += (oa[c][0] * oa[c][0] + oa[c][1] * oa[c][1]) + (oa[c][2] * oa[c][2] + oa[c][3] * oa[c][3]);
            q += __shfl_xor(q, 16); q += __shfl_xor(q, 32);
            if (fq == 0) ((LAS float*)(lds + HG_RSS))[(tt * 16 + fr) * 2 + vh] = q;
        }
        {
#pragma unroll
            for (int a = 0; a < 2; ++a) { const f32x4 dl = *(const LAS f32x4*)(lds + HG_DL + ((kp * 2 + a) * 16 + fq * 4) * 4);
#pragma unroll
                for (int c = 0; c < 4; ++c) sacc[a][c] = sacc[a][c] * dl; }
#pragma unroll
            for (int t2 = 0; t2 < 2; ++t2) {
                bf16x8 af[2], bv[4];
#pragma unroll
                for (int a = 0; a < 2; ++a) af[a] = *(const LAS bf16x8*)(lds + HG_KLT + ((kp * 2 + a) * 16 + fr) * PT + t2 * 64 + fq * 16);
#pragma unroll
                for (int c = 0; c < 4; ++c) bv[c] = *(const LAS bf16x8*)(lds + HG_VT + ((vh * 4 + c) * 16 + fr) * PT + t2 * 64 + fq * 16);
#pragma unroll
                for (int a = 0; a < 2; ++a)
#pragma unroll
                    for (int c = 0; c < 4; ++c) sacc[a][c] = __builtin_amdgcn_mfma_f32_16x16x32_bf16(af[a], bv[c], sacc[a][c], 0, 0, 0);
            }
        }
    }
    BAR_LDS();
    HG_READOUT();
    float* so = P.out + (kind == 0 ? OFF_PST : OFF_SST) + (size_t)(b * 4 + h) * 16384;
    BAR_LDS();
#pragma unroll
    for (int a = 0; a < 2; ++a)
#pragma unroll
        for (int c = 0; c < 4; ++c)
#pragma unroll
            for (int j = 0; j < 4; ++j) ((LAS float*)lds)[((kp * 2 + a) * 16 + fq * 4 + j) * 132 + (vh * 4 + c) * 16 + fr] = sacc[a][c][j];
    BAR_LDS();
#pragma unroll
    for (int i = 0; i < 8; ++i) { const int idx = tid + i * 512, r = idx >> 5, c4 = idx & 31;
        *(f32x4*)(so + (size_t)r * 128 + c4 * 4) = *(const LAS f32x4*)(lds + (r * 132 + c4 * 4) * 4); }
    __syncthreads();
}

constexpr int AT_K = 0, AT_V = 56576;
constexpr int PKA = 272, PVA = 472;

__device__ __forceinline__ void attn_unit(const Params& P, LAS unsigned char* lds, int kind, int b, int c) {
    const int tid = threadIdx.x, lane = tid & 63, w = __builtin_amdgcn_readfirstlane(tid >> 6), fr = lane & 15, fq = lane >> 4;
    unsigned char* ws = P.ws;
    const bf16_t* AQ = (const bf16_t*)(ws + WS_AQ); const bf16_t* AK = (const bf16_t*)(ws + WS_AK); const bf16_t* AV = (const bf16_t*)(ws + WS_AV);
    bf16_t* MIX = (bf16_t*)(ws + WS_MIX);
    const int nqt = kind == 0 ? 2 : 1;
    const int tl = fr >> 2, hr = fr & 3;
    bf16x8 qf[2][2][2];
#pragma unroll
    for (int qt = 0; qt < 2; ++qt) { const int t = kind == 0 ? w * 8 + qt * 4 + tl : w * 4 + tl;
        const size_t row = kind == 0 ? (size_t)b * SEQ + c * 64 + t : (size_t)ROW_S + b * DSEQ + t;
#pragma unroll
        for (int g = 0; g < 2; ++g)
#pragma unroll
            for (int dd = 0; dd < 2; ++dd) qf[qt][g][dd] = (qt < nqt) ? *(const bf16x8*)(AQ + row * 512 + (g * 4 + hr) * 64 + dd * 32 + fq * 8) : (bf16x8){0, 0, 0, 0, 0, 0, 0, 0}; }
    __syncthreads();
    {
        u32x4 kq[7], vq[7];
#pragma unroll
        for (int it = 0; it < 7; ++it) {
            kq[it] = (u32x4){0u, 0u, 0u, 0u}; vq[it] = (u32x4){0u, 0u, 0u, 0u};
            const int idx = tid + it * 512, jk = idx >> 4, pck = idx & 15;
            const int jv = it * 32 + (lane & 31), pcv = w * 2 + (lane >> 5);
            if (kind == 0) {
                int rk = -1, rv = -1;
                if (jk < 16) rk = ROW_M + jk; else if (jk < 208) { const int sq = (c - 2) * 64 + (jk - 16); if (sq >= 0) rk = b * SEQ + sq; }
                if (jv < 16) rv = ROW_M + jv; else if (jv < 208) { const int sq = (c - 2) * 64 + (jv - 16); if (sq >= 0) rv = b * SEQ + sq; }
                const u32x4 kl = *(const u32x4*)(AK + (size_t)(rk >= 0 ? rk : 0) * 128 + pck * 8), vl = *(const u32x4*)(AV + (size_t)(rv >= 0 ? rv : 0) * 128 + pcv * 8);
                if (rk >= 0) kq[it] = kl;
                if (rv >= 0) vq[it] = vl;
            } else {
                if (jk < 144) { const float* kp_ = jk < 16 ? P.in[2] + (size_t)(b * 16 + jk) * 128 : P.in[4] + (size_t)(b * 128 + jk - 16) * 128;
                    kq[it] = pack8(*(const f32x4*)(kp_ + pck * 8), *(const f32x4*)(kp_ + pck * 8 + 4)); }
                else if (jk < 176) kq[it] = *(const u32x4*)(AK + (size_t)(ROW_S + b * DSEQ + (jk - 144)) * 128 + pck * 8);
                if (jv < 144) { const float* vp_ = jv < 16 ? P.in[3] + (size_t)(b * 16 + jv) * 128 : P.in[5] + (size_t)(b * 128 + jv - 16) * 128;
                    vq[it] = pack8(*(const f32x4*)(vp_ + pcv * 8), *(const f32x4*)(vp_ + pcv * 8 + 4)); }
                else if (jv < 176) vq[it] = *(const u32x4*)(AV + (size_t)(ROW_S + b * DSEQ + (jv - 144)) * 128 + pcv * 8);
            }
        }
#pragma unroll
        for (int it = 0; it < 7; ++it) {
            const int idx = tid + it * 512, jk = idx >> 4, pck = idx & 15;
            const int jv = it * 32 + (lane & 31), pcv = w * 2 + (lane >> 5);
            if (jk < 208) *(LAS u32x4*)(lds + AT_K + jk * PKA + pck * 16) = kq[it];
#pragma unroll
            for (int e = 0; e < 4; ++e) { const unsigned u = vq[it][e];
                *(LAS bf16_t*)(lds + AT_V + (pcv * 8 + 2 * e) * PVA + jv * 2) = (bf16_t)(u & 0xffffu);
                *(LAS bf16_t*)(lds + AT_V + (pcv * 8 + 2 * e + 1) * PVA + jv * 2) = (bf16_t)(u >> 16); }
        }
    }
    __syncthreads();
    unsigned vmask;
    if (kind == 0) vmask = 0x1u | (c >= 2 ? 0x1eu : 0u) | (c >= 1 ? 0x1e0u : 0u) | 0x1e00u; else vmask = 0x7ffu;
    const float* sinks = P.in[12]; const float* an = P.in[13];
    for (int qt = 0; qt < nqt; ++qt) {
        const int t = kind == 0 ? w * 8 + qt * 4 + tl : w * 4 + tl;
        const size_t row = kind == 0 ? (size_t)b * SEQ + c * 64 + t : (size_t)ROW_S + b * DSEQ + t;
        f32x4 oacc[2][4];
#pragma unroll
        for (int g = 0; g < 2; ++g) {
            bf16x8 qsel[2];
#pragma unroll
            for (int dd = 0; dd < 2; ++dd) qsel[dd] = qt == 0 ? qf[0][g][dd] : qf[1][g][dd];
            f32x4 sa[13];
#pragma unroll
            for (int kt = 0; kt < 13; ++kt) { sa[kt] = (f32x4){0.f, 0.f, 0.f, 0.f};
#pragma unroll
                for (int dd = 0; dd < 2; ++dd) { const bf16x8 kf = *(const LAS bf16x8*)(lds + AT_K + (kt * 16 + fr) * PKA + g * 128 + dd * 64 + fq * 16);
                    sa[kt] = __builtin_amdgcn_mfma_f32_16x16x32_bf16(kf, qsel[dd], sa[kt], 0, 0, 0); } }
            const float sink = sinks[g * 4 + hr] * LOG2E;
            float mx = sink;
#pragma unroll
            for (int kt = 0; kt < 13; ++kt) { const float nb = ((vmask >> kt) & 1u) ? 0.f : -1e30f;
                sa[kt] = sa[kt] + nb;
                mx = fmaxf(fmaxf(mx, fmaxf(sa[kt][0], sa[kt][1])), fmaxf(sa[kt][2], sa[kt][3])); }
            mx = fmaxf(mx, __shfl_xor(mx, 16)); mx = fmaxf(mx, __shfl_xor(mx, 32));
            float sum = 0.f;
#pragma unroll
            for (int kt = 0; kt < 13; ++kt) {
#pragma unroll
                for (int j = 0; j < 4; ++j) sa[kt][j] = __builtin_amdgcn_exp2f(sa[kt][j] - mx);
                sum += (sa[kt][0] + sa[kt][1]) + (sa[kt][2] + sa[kt][3]);
            }
            sum += __shfl_xor(sum, 16); sum += __shfl_xor(sum, 32);
            const float inv = 1.0f / (sum + __builtin_amdgcn_exp2f(sink - mx));
            bf16x8 pb[7];
#pragma unroll
            for (int kp = 0; kp < 7; ++kp) { const f32x4 p0 = sa[2 * kp], p1 = (2 * kp + 1 < 13) ? sa[(2 * kp + 1 < 13) ? 2 * kp + 1 : 0] : (f32x4){0.f, 0.f, 0.f, 0.f};
                const u32x4 u = pack8(p0, p1); pb[kp] = __builtin_bit_cast(bf16x8, u); }
#pragma unroll
            for (int dt = 0; dt < 4; ++dt) { oacc[g][dt] = (f32x4){0.f, 0.f, 0.f, 0.f};
#pragma unroll
                for (int kp = 0; kp < 7; ++kp) {
                    const s16x4 v0 = *(const LAS s16x4*)(lds + AT_V + (g * 64 + dt * 16 + fr) * PVA + (2 * kp) * 32 + fq * 8);
                    const s16x4 v1 = *(const LAS s16x4*)(lds + AT_V + (g * 64 + dt * 16 + fr) * PVA + (2 * kp + 1) * 32 + fq * 8);
                    const bf16x8 vf = __builtin_shufflevector(v0, v1, 0, 1, 2, 3, 4, 5, 6, 7);
                    oacc[g][dt] = __builtin_amdgcn_mfma_f32_16x16x32_bf16(vf, pb[kp], oacc[g][dt], 0, 0, 0); }
                oacc[g][dt] = oacc[g][dt] * inv; }
        }
        float ss = 0.f;
#pragma unroll
        for (int g = 0; g < 2; ++g)
#pragma unroll
            for (int dt = 0; dt < 4; ++dt) ss += (oacc[g][dt][0] * oacc[g][dt][0] + oacc[g][dt][1] * oacc[g][dt][1]) + (oacc[g][dt][2] * oacc[g][dt][2] + oacc[g][dt][3] * oacc[g][dt][3]);
        ss += __shfl_xor(ss, 16); ss += __shfl_xor(ss, 32); ss += __shfl_xor(ss, 1); ss += __shfl_xor(ss, 2);
        const float rs = rsqrtf(ss * (1.0f / 512.0f) + EPS);
#pragma unroll
        for (int g = 0; g < 2; ++g)
#pragma unroll
            for (int dt = 0; dt < 4; dt += 2) {
                const int col = (g * 4 + hr) * 64 + dt * 16 + fq * 4;
                const u32x2 p0 = pack4(oacc[g][dt] * rs * *(const f32x4*)(an + col)), p1 = pack4(oacc[g][dt + 1] * rs * *(const f32x4*)(an + col + 16));
                const auto sx = __builtin_amdgcn_permlane16_swap(p0.x, p1.x, false, false), sy = __builtin_amdgcn_permlane16_swap(p0.y, p1.y, false, false);
                const int cw = (g * 4 + hr) * 64 + ((fq & 1) ? (dt + 1) * 16 + (fq - 1) * 4 : dt * 16 + fq * 4);
                *(u32x4*)(MIX + row * DM + 512 + cw) = (u32x4){sx[0], sy[0], sx[1], sy[1]}; }
    }
}

__device__ __forceinline__ void p2_phase(const Params& P, LAS unsigned char* lds, int rep, bool do_hgrn, bool do_attn) {
    unsigned char* ws = P.ws; const int G = gridDim.x, bid = blockIdx.x;
    if (do_hgrn) {
        {
            const bf16_t* AK = (const bf16_t*)(ws + WS_AK); const bf16_t* AV = (const bf16_t*)(ws + WS_AV);
            constexpr int NPW = NBATCH * 128 * 16, NSN = DBATCH * DSEQ * 16, NPM = NBATCH * NMETA * 16;
            for (int i = bid * 512 + threadIdx.x; i < NPW + NSN + NPM; i += G * 512) {
                int src_row; size_t dk, dv; const int pc = i & 15;
                if (i < NPW) { const int r = i >> 4, b = r >> 7, s = r & 127; src_row = b * SEQ + (SEQ - 128) + s; dk = OFF_PWK + (size_t)r * 128; dv = OFF_PWV + (size_t)r * 128; }
                else if (i < NPW + NSN) { const int r = (i - NPW) >> 4; src_row = ROW_S + r; dk = OFF_SNK + (size_t)r * 128; dv = OFF_SNV + (size_t)r * 128; }
                else { const int r = (i - NPW - NSN) >> 4, m = r & 15; src_row = ROW_M + m; dk = OFF_PMK + (size_t)r * 128; dv = OFF_PMV + (size_t)r * 128; }
                const u32x4 kq = *(const u32x4*)(AK + (size_t)src_row * 128 + pc * 8), vq = *(const u32x4*)(AV + (size_t)src_row * 128 + pc * 8);
                float* ko = P.out + dk + pc * 8; float* vo = P.out + dv + pc * 8;
                *(f32x4*)ko = (f32x4){bflo(kq.x), bfhi(kq.x), bflo(kq.y), bfhi(kq.y)}; *(f32x4*)(ko + 4) = (f32x4){bflo(kq.z), bfhi(kq.z), bflo(kq.w), bfhi(kq.w)};
                *(f32x4*)vo = (f32x4){bflo(vq.x), bfhi(vq.x), bflo(vq.y), bfhi(vq.y)}; *(f32x4*)(vo + 4) = (f32x4){bflo(vq.z), bfhi(vq.z), bflo(vq.w), bfhi(vq.w)};
            }
        }
    }
    {
        if (do_hgrn) for (int u = bid; u < 160; u += G) hgrn_unit(P, lds, u < 128 ? 0 : 1, u < 128 ? (u >> 2) : ((u - 128) >> 2), u & 3);
        unsigned* ctr = (unsigned*)(ws + WS_CTL) + rep;
        LAS unsigned* slot = (LAS unsigned*)(lds + LDS_BYTES - 64);
        if (do_attn) for (;;) {
            __syncthreads();
            if (threadIdx.x == 0) *slot = atomicAdd(ctr, 1u);
            __syncthreads();
            const unsigned u = *slot;
            if (u >= 8u + 1024u) break;
            if (u < 8u) attn_unit(P, lds, 1, (int)u, 0); else attn_unit(P, lds, 0, (int)((u - 8u) >> 5), (int)((u - 8u) & 31u));
        }
    }
}

#define XB_TMO      128
#define XB_XCNT(j)  (256  + 64 * (j))
#define XB_XSUB(j)  (1280 + 64 * (j))
#define XB_XGEN(j)  (2304 + 64 * (j))
#define XB_TOP      3328
#define XB_TOPGEN   3392
#define XCD_BAR_WORDS 3456
#define XB_SPIN_CAP (1u << 18)
static_assert(XCD_BAR_WORDS * 4 <= WS_BAR_BYTES, "barrier words");
__device__ __forceinline__ unsigned xb_ld(unsigned* p)              { return __hip_atomic_load(p, __ATOMIC_RELAXED, __HIP_MEMORY_SCOPE_AGENT); }
__device__ __forceinline__ unsigned xb_add(unsigned* p, unsigned v) { return __hip_atomic_fetch_add(p, v, __ATOMIC_RELAXED, __HIP_MEMORY_SCOPE_AGENT); }
__device__ __forceinline__ unsigned xb_xcc_id() { return (unsigned)__builtin_amdgcn_s_getreg((3 << 11) | 20) & 0xFu; }
#define XB_SPIN(cond, bar) do { unsigned _sp = 0; while (cond) { __builtin_amdgcn_s_sleep(1); \
    if ((++_sp & 255u) == 0u) { if (xb_ld(&(bar)[XB_TMO])) break; if (_sp > XB_SPIN_CAP) { atomicAdd(&(bar)[XB_TMO], 1u); break; } } } } while (0)
struct XcdBarrier { unsigned* bar; unsigned x; volatile LAS unsigned* st; };
__device__ __forceinline__ XcdBarrier xcd_barrier_post(unsigned* bar, volatile LAS unsigned* st) {
    XcdBarrier b; b.bar = bar; b.x = xb_xcc_id(); b.st = st;
    if (threadIdx.x == 0) (void)xb_add(&bar[XB_XCNT(b.x)], 1u);
    return b;
}
__device__ __forceinline__ void xcd_barrier_complete(unsigned* bar, unsigned x, unsigned& nloc, unsigned& nx) {
    const unsigned G = gridDim.x * gridDim.y * gridDim.z;
    unsigned sum, cnt, mine, sp = 0u;
    for (;;) {
        sum = 0u; cnt = 0u; mine = 0u;
#pragma unroll
        for (unsigned j = 0; j < 16; ++j) { const unsigned c = xb_ld(&bar[XB_XCNT(j)]); sum += c; cnt += (c > 0u) ? 1u : 0u; mine = (j == x) ? c : mine; }
        if (sum == G) break;
        __builtin_amdgcn_s_sleep(1);
        if ((++sp & 255u) == 0u) { if (xb_ld(&bar[XB_TMO])) break; if (sp > XB_SPIN_CAP) { atomicAdd(&bar[XB_TMO], 1u); break; } }
    }
    nloc = mine > 0u ? mine : 1u; nx = cnt > 0u ? cnt : 1u;
}
__device__ __forceinline__ void xcd_barrier(const XcdBarrier& b) {
    asm volatile("s_waitcnt vmcnt(0)" ::: "memory");
    __syncthreads();
    if (threadIdx.x == 0) {
        unsigned* bar = b.bar;
        __builtin_amdgcn_s_waitcnt(0);
        unsigned nloc = b.st[0], nx = b.st[1];
        if (nloc == 0u) { xcd_barrier_complete(bar, b.x, nloc, nx); b.st[0] = nloc; b.st[1] = nx; }
        const unsigned old = xb_add(&bar[XB_XSUB(b.x)], 1u);
        const unsigned gen = old / nloc;
        if (old + 1u == (gen + 1u) * nloc) {
            __builtin_amdgcn_fence(__ATOMIC_RELEASE, "agent");
            asm volatile("s_waitcnt vmcnt(0)" ::: "memory");
            const unsigned og = xb_add(&bar[XB_TOP], 1u);
            const unsigned tg = og / nx;
            if (og + 1u == (tg + 1u) * nx) xb_add(&bar[XB_TOPGEN], 1u);
            else XB_SPIN(xb_ld(&bar[XB_TOPGEN]) == tg, bar);
            __builtin_amdgcn_fence(__ATOMIC_ACQUIRE, "agent");
            xb_add(&bar[XB_XGEN(b.x)], 1u);
            asm volatile("s_waitcnt vmcnt(0)" ::: "memory");
        } else {
            XB_SPIN(xb_ld(&bar[XB_XGEN(b.x)]) == gen, bar);
            __builtin_amdgcn_fence(__ATOMIC_ACQUIRE, "agent");
            asm volatile("s_waitcnt vmcnt(0)" ::: "memory");
        }
    }
    __syncthreads();
}

__global__ void __launch_bounds__(512, 2) hymba_fwd(Params P) {
    extern __shared__ __attribute__((aligned(16))) unsigned char smem[];
    LAS unsigned char* lds = (LAS unsigned char*)smem;
    cg::grid_group grid = cg::this_grid();
    unsigned char* ws = P.ws;
    const int G = gridDim.x, bid = blockIdx.x;
    volatile LAS unsigned* xst = (volatile LAS unsigned*)(lds + LDS_BYTES - 32);
    if (threadIdx.x == 0) { xst[0] = 0u; xst[1] = 0u; }
    __syncthreads();
    const XcdBarrier xbar = xcd_barrier_post((unsigned*)(ws + WS_BAR), xst);

    p0_prologue(P, lds);
    xcd_barrier(xbar);

    {
        pg8::Gemm g{(const bf16_t*)(ws + WS_XN), (const bf16_t*)(ws + WS_WIN), RTOT, NIN, DM}; pg8::StaticOrder S; S.init(RTOT, NIN, DM, G, bid);
        EpiIn E{ws, P.out};
#pragma unroll 1
        for (int rep = 0; rep < REP_P1; ++rep) { pg8::gemm_phase<EpiIn, pg8::StaticOrder>(lds, g, S, E); if (rep + 1 < REP_P1) grid.sync(); }
    }
    xcd_barrier(xbar);

    p2_phase(P, lds, 0, true, true);
#if REP_P2 > 1
    grid.sync();
    p2_phase(P, lds, 1, false, true);
#endif
    xcd_barrier(xbar);

    {
        pg8::Gemm g{(const bf16_t*)(ws + WS_MIX), (const bf16_t*)(ws + WS_WOUT), MROWS, DM, DM}; pg8::StaticOrder S; S.init(MROWS, DM, DM, G, bid);
        EpiOut E{(bf16_t*)(ws + WS_XN), (float*)(ws + WS_SS1), (const float*)(ws + WS_SS2), (const float*)(ws + WS_GINV)};
        pg8::gemm_phase<EpiOut, pg8::StaticOrder>(lds, g, S, E);
    }
    xcd_barrier(xbar);

    {
        {
            const bf16_t* HBs = (const bf16_t*)(ws + WS_XN) + (size_t)ROW_S * DM; float* Ys = P.out + OFF_Y + (size_t)ROW_S * DM;
            int t2 = threadIdx.x; asm volatile("" : "+v"(t2));
            for (int i = bid * 512 + t2; i < DBATCH * DSEQ * DM / 8; i += G * 512) { const u32x4 hb = *(const u32x4*)(HBs + (size_t)i * 8);
                *(f32x4*)(Ys + (size_t)i * 8) = (f32x4){bflo(hb.x), bfhi(hb.x), bflo(hb.y), bfhi(hb.y)}; *(f32x4*)(Ys + (size_t)i * 8 + 4) = (f32x4){bflo(hb.z), bfhi(hb.z), bflo(hb.w), bfhi(hb.w)}; }
        }
        pg8::Gemm g{(const bf16_t*)(ws + WS_XN), (const bf16_t*)(ws + WS_WFI), MROWS, NFF2, DM}; pg8::StaticOrder S; S.init(MROWS, NFF2, DM, G, bid);
        EpiSwi E{(bf16_t*)(ws + WS_ACT), (float*)(ws + WS_SS1)};
#pragma unroll 1
        for (int rep = 0; rep < REP_P4; ++rep) { pg8::gemm_phase<EpiSwi, pg8::StaticOrder>(lds, g, S, E); if (rep + 1 < REP_P4) grid.sync(); }
    }
    xcd_barrier(xbar);

    {
        pg8::Gemm g{(const bf16_t*)(ws + WS_ACT), (const bf16_t*)(ws + WS_WFO), MROWS, DM, DFF}; pg8::DownOrder S; S.init(G, bid);
        const int fused = (G == 256) ? 1 : 0;
        EpiDown E{P.out + OFF_Y, (const bf16_t*)(ws + WS_XN), (unsigned*)(ws + WS_CTL) + 16, P.in[18], (float*)(ws + WS_MIX), (LAS float*)(lds + 131072), fused};
        pg8::gemm_phase<EpiDown, pg8::DownOrder>(lds, g, S, E);
        {
            xcd_barrier(xbar);
            int t2 = threadIdx.x; asm volatile("" : "+v"(t2));
            const int lane = t2 & 63, gw = bid * 8 + (t2 >> 6), NGW = G * 8;
            f32x4 gv[4];
#pragma unroll
            for (int j = 0; j < 4; ++j) gv[j] = *(const f32x4*)(P.in[18] + 4 * lane + 256 * j);
            for (int r4 = ROW_S / 4 + gw; r4 < MROWS / 4; r4 += NGW) norm_rows<4>(P.out + OFF_Y + (size_t)r4 * 4 * DM, gv, lane);
            if (!fused) {
                const bf16_t* H2 = (const bf16_t*)(ws + WS_XN); float* Yp = P.out + OFF_Y;
                f32x4 fg[2][2];
#pragma unroll
                for (int hh = 0; hh < 2; ++hh) { fg[hh][0] = *(const f32x4*)(P.in[18] + hh * 512 + 8 * lane); fg[hh][1] = *(const f32x4*)(P.in[18] + hh * 512 + 8 * lane + 4); }
                for (int r4 = gw; r4 < ROW_S / 4; r4 += NGW) {
                    u32x4 hb[4][2];
#pragma unroll
                    for (int rr = 0; rr < 4; ++rr)
#pragma unroll
                        for (int hh = 0; hh < 2; ++hh) hb[rr][hh] = *(const u32x4*)(H2 + (size_t)(r4 * 4 + rr) * DM + hh * 512 + 8 * lane);
#pragma unroll
                    for (int rr = 0; rr < 4; ++rr) { f32x4 v[2][2]; float q = 0.f;
#pragma unroll
                        for (int hh = 0; hh < 2; ++hh) { v[hh][0] = (f32x4){bflo(hb[rr][hh].x), bfhi(hb[rr][hh].x), bflo(hb[rr][hh].y), bfhi(hb[rr][hh].y)}; v[hh][1] = (f32x4){bflo(hb[rr][hh].z), bfhi(hb[rr][hh].z), bflo(hb[rr][hh].w), bfhi(hb[rr][hh].w)};
                            q += (v[hh][0][0] * v[hh][0][0] + v[hh][0][1] * v[hh][0][1]) + (v[hh][0][2] * v[hh][0][2] + v[hh][0][3] * v[hh][0][3]) + (v[hh][1][0] * v[hh][1][0] + v[hh][1][1] * v[hh][1][1]) + (v[hh][1][2] * v[hh][1][2] + v[hh][1][3] * v[hh][1][3]); }
                        const float rs = rsqrtf(wave_sum(q) * (1.0f / DM) + EPS);
                        float* yr = Yp + (size_t)(r4 * 4 + rr) * DM + 8 * lane;
#pragma unroll
                        for (int hh = 0; hh < 2; ++hh) { *(f32x4*)(yr + hh * 512) = v[hh][0] * rs * fg[hh][0]; *(f32x4*)(yr + hh * 512 + 4) = v[hh][1] * rs * fg[hh][1]; } }
                }
            }
        }
    }

}

extern "C" void kernel_launch(void* const* d_in, const int* in_sizes, int n_in, void* d_out, int out_size, void* d_ws, size_t ws_size, hipStream_t stream) {
    static int grid = 0;
    if (grid == 0) {
        int dev = 0, cus = 0, per_cu = 0;
        hipGetDevice(&dev);
        hipDeviceGetAttribute(&cus, hipDeviceAttributeMultiprocessorCount, dev);
        hipFuncSetAttribute((const void*)hymba_fwd, hipFuncAttributeMaxDynamicSharedMemorySize, LDS_BYTES);
        hipOccupancyMaxActiveBlocksPerMultiprocessor(&per_cu, (const void*)hymba_fwd, 512, LDS_BYTES);
        if (per_cu < 1) { fprintf(stderr, "occupancy query reports %d blocks per CU\n", per_cu); per_cu = 1; }
        (void)hipGetLastError();
        grid = cus;
        if (ws_size < WS_END) fprintf(stderr, "workspace too small: %zu < %zu\n", ws_size, (size_t)WS_END);
    }
    Params p{};
    for (int i = 0; i < 19; ++i) p.in[i] = (const float*)d_in[i];
    p.out = (float*)d_out; p.ws = (unsigned char*)d_ws;
    if (hipMemsetAsync((unsigned char*)d_ws + WS_BAR, 0, WS_BAR_BYTES, stream) != hipSuccess) fprintf(stderr, "hipMemsetAsync of the barrier words failed\n");
    void* args[] = {&p};
    hipError_t e = hipLaunchCooperativeKernel((const void*)hymba_fwd, dim3(grid), dim3(512), args, LDS_BYTES, stream);
    if (e != hipSuccess) fprintf(stderr, "cooperative launch failed: %s (grid %d)\n", hipGetErrorString(e), grid);
}
```
